# Optimizing an MI355X kernel written in HIP

```python
import jax, jax.numpy as jnp
from jax import lax
import numpy as np

D_MODEL = 1024
BATCH = 4
SEQ = 4096
DEPTH = 4

MEM_LEN = 256
MIX_W = D_MODEL // 2
N_BRANCH = 4
CONV_W = MIX_W
CONV_K = 31
DN_HEADS = 4
DN_HEAD_DIM = MIX_W // DN_HEADS
DN_CONV_K = 4
DN_CHUNK = 64
GM_W = MIX_W
GM_GROUPS = 4
GM_CHUNK = 128
POOL_W = MIX_W
POOL_WINDOWS = (2, 4, 8, 16)
POOL_GROUPS = len(POOL_WINDOWS)
XA_HEADS = 4
XA_HEAD_DIM = D_MODEL // XA_HEADS
FFN_W = 4 * D_MODEL
IN_W = 2 * CONV_W + 4 * MIX_W + 2 * DN_HEADS + 2 * GM_W + POOL_W + N_BRANCH * D_MODEL

kernel_name = 'hybrid_gated_conv_deltanet_gmlp_pool_trunk'


def rmsnorm(x, g, eps=1e-6):
    xf = x.astype(jnp.float32)
    y = xf * lax.rsqrt(jnp.mean(xf * xf, axis=-1, keepdims=True) + eps)
    return (y * g.astype(jnp.float32)).astype(x.dtype)


def layernorm(x, g, b, eps=1e-5):
    xf = x.astype(jnp.float32)
    mu = jnp.mean(xf, axis=-1, keepdims=True)
    var = jnp.mean(jnp.square(xf - mu), axis=-1, keepdims=True)
    y = (xf - mu) * lax.rsqrt(var + eps)
    return (y * g.astype(jnp.float32) + b.astype(jnp.float32)).astype(x.dtype)


def causal_dwconv(x, w):
    K, C = w.shape
    return lax.conv_general_dilated(x, w[:, None, :].astype(x.dtype), window_strides=(1,),
                                    padding=[(K - 1, 0)],
                                    dimension_numbers=('NWC', 'WIO', 'NWC'),
                                    feature_group_count=C)


def gated_delta_rule(q, k, v, g, beta):
    B, S, H, Dk = q.shape
    Dv = v.shape[-1]
    C = DN_CHUNK
    N = S // C
    f32 = jnp.float32
    q = q.astype(f32)
    k = k.astype(f32)
    q = q * lax.rsqrt(jnp.sum(q * q, -1, keepdims=True) + 1e-6) * (Dk ** -0.5)
    k = k * lax.rsqrt(jnp.sum(k * k, -1, keepdims=True) + 1e-6)

    def chunks(t):
        t = t.astype(f32).reshape((B, N, C, H) + t.shape[3:])
        return jnp.moveaxis(t, 3, 2)

    q, k, v, g, beta = chunks(q), chunks(k), chunks(v), chunks(g), chunks(beta)
    gam = jnp.cumsum(g, axis=-1)
    causal = jnp.tril(jnp.ones((C, C), bool))
    strict = jnp.tril(jnp.ones((C, C), bool), -1)
    decay = jnp.exp(jnp.where(causal, gam[..., :, None] - gam[..., None, :], -jnp.inf))
    kb = k * beta[..., None]
    a = jnp.where(strict, jnp.einsum('bnhid,bnhjd->bnhij', kb, k) * decay, 0.0)
    rhs = jnp.concatenate([v * beta[..., None], kb * jnp.exp(gam)[..., None]], axis=-1)
    sol = lax.linalg.triangular_solve(a + jnp.eye(C, dtype=f32), rhs, left_side=True,
                                      lower=True, unit_diagonal=True)
    u, w = sol[..., :Dv], sol[..., Dv:]
    attn = jnp.einsum('bnhid,bnhjd->bnhij', q, k) * decay
    q_dec = q * jnp.exp(gam)[..., None]
    g_last = gam[..., -1]
    k_dec = k * jnp.exp(g_last[..., None] - gam)[..., None]

    def step(state, xs):
        u_n, w_n, attn_n, qd_n, kd_n, gl_n = xs
        v_new = u_n - jnp.einsum('bhck,bhkv->bhcv', w_n, state)
        o_n = (jnp.einsum('bhck,bhkv->bhcv', qd_n, state)
               + jnp.einsum('bhij,bhjv->bhiv', attn_n, v_new))
        state = (state * jnp.exp(gl_n)[..., None, None]
                 + jnp.einsum('bhck,bhcv->bhkv', kd_n, v_new))
        return state, o_n

    xs = tuple(jnp.moveaxis(t, 1, 0) for t in (u, w, attn, q_dec, k_dec, g_last))
    state0 = jnp.zeros((B, H, Dk, Dv), f32)
    _, o = lax.scan(step, state0, xs)
    return jnp.transpose(o, (1, 0, 3, 2, 4)).reshape(B, S, H, Dv)


def multiscale_pool(x):
    B, S, C = x.shape
    Cg = C // POOL_GROUPS
    xf = x.astype(jnp.float32).reshape(B, S, POOL_GROUPS, Cg)
    cs = jnp.cumsum(xf, axis=1)
    cs_pad = jnp.concatenate([jnp.zeros((B, 1, POOL_GROUPS, Cg), jnp.float32), cs], axis=1)
    t = jnp.arange(S)
    outs = []
    for gi, win in enumerate(POOL_WINDOWS):
        upper = cs[:, :, gi]
        lower = jnp.concatenate([jnp.zeros((B, win - 1, Cg), jnp.float32),
                                 cs_pad[:, :S - win + 1, gi]], axis=1)
        count = jnp.minimum(t + 1, win).astype(jnp.float32)[None, :, None]
        outs.append((upper - lower) / count)
    return (jnp.stack(outs, axis=2) - xf).astype(x.dtype)


def hybrid_mixer(h, w_in, conv_a_w, conv_a_b, ln_a_g, ln_a_b, dn_conv_w, dn_a_log, dn_dt_bias,
                 dn_norm_g, gm_ln_g, gm_ln_b, gm_ws, gm_bs, pool_w, pool_scale, w_branch, w_out):
    B, S, _ = h.shape
    f32 = jnp.float32
    z = h @ w_in
    sizes = [2 * CONV_W, MIX_W, MIX_W, MIX_W, MIX_W, DN_HEADS, DN_HEADS, 2 * GM_W, POOL_W,
             N_BRANCH * D_MODEL]
    idx = np.cumsum(sizes)[:-1].tolist()
    a_in, dq, dk, dv, dgate, dbeta, da, gm_in, pool_in, gate_in = jnp.split(z, idx, axis=-1)

    a1, a2 = jnp.split(a_in, 2, axis=-1)
    a = a1 * jax.nn.sigmoid(a2)
    a = causal_dwconv(a, conv_a_w) + conv_a_b
    a = jax.nn.silu(layernorm(a, ln_a_g, ln_a_b))

    qkv = jax.nn.silu(causal_dwconv(jnp.concatenate([dq, dk, dv], axis=-1), dn_conv_w))
    q, k, v = jnp.split(qkv, 3, axis=-1)
    heads = lambda t: t.reshape(B, S, DN_HEADS, DN_HEAD_DIM)
    beta = jax.nn.sigmoid(dbeta.astype(f32))
    g = -jnp.exp(dn_a_log.astype(f32)) * jax.nn.softplus(da.astype(f32) + dn_dt_bias.astype(f32))
    o = gated_delta_rule(heads(q), heads(k), heads(v), g, beta)
    o = rmsnorm(o, dn_norm_g) * jax.nn.silu(heads(dgate).astype(f32))
    o = o.reshape(B, S, MIX_W).astype(h.dtype)

    u, vg = jnp.split(jax.nn.gelu(gm_in, approximate=False), 2, axis=-1)
    vg = layernorm(vg, gm_ln_g, gm_ln_b)
    vc = vg.reshape(B, S // GM_CHUNK, GM_CHUNK, GM_GROUPS, GM_W // GM_GROUPS)
    ws = gm_ws * jnp.tril(jnp.ones((GM_CHUNK, GM_CHUNK), gm_ws.dtype))
    mixed = jnp.einsum('gts,bnsgc->bntgc', ws, vc) + gm_bs.T[:, :, None]
    c = u * mixed.reshape(B, S, GM_W)

    p = multiscale_pool(pool_in)
    p = jnp.einsum('bsgc,gcd->bsgd', p, pool_w).reshape(B, S, POOL_W) * pool_scale

    gates = jax.nn.sigmoid(gate_in).reshape(B, S, N_BRANCH, D_MODEL)
    br = jnp.stack([a, o, c, p], axis=2)
    proj = jnp.einsum('bsnc,ncd->bsnd', br, w_branch)
    merged = jnp.sum(gates * proj, axis=2)
    return merged @ w_out


def memory_cross_attention(h, mem, norm_mem, wq, wkv, wo):
    B, S, _ = h.shape
    M = mem.shape[1]
    m = rmsnorm(mem, norm_mem)
    q = (h @ wq).reshape(B, S, XA_HEADS, XA_HEAD_DIM)
    k, v = jnp.split(m @ wkv, 2, axis=-1)
    k = k.reshape(B, M, XA_HEADS, XA_HEAD_DIM)
    v = v.reshape(B, M, XA_HEADS, XA_HEAD_DIM)
    s = jnp.einsum('bshd,bmhd->bhsm', q, k).astype(jnp.float32) * (XA_HEAD_DIM ** -0.5)
    pr = jax.nn.softmax(s, axis=-1).astype(v.dtype)
    o = jnp.einsum('bhsm,bmhd->bshd', pr, v).reshape(B, S, D_MODEL)
    return o @ wo


def squared_relu_mlp(h, w1, w2):
    return jnp.square(jax.nn.relu(h @ w1)) @ w2


def setup_inputs(seed: int = 0) -> dict:
    key = jax.random.key(seed)
    ks = jax.random.split(key, 40)
    f32 = jnp.float32
    L, D = DEPTH, D_MODEL
    nrm = lambda i, shape, scale: jax.random.normal(ks[i], shape, f32) * scale
    gain = lambda i, shape: 1.0 + 0.1 * jax.random.normal(ks[i], shape, f32)
    dt = jnp.exp(jax.random.uniform(ks[10], (L, DN_HEADS), f32) * (np.log(0.1) - np.log(0.001))
                 + np.log(0.001))
    return {
        'x': nrm(0, (BATCH, SEQ, D), 1.0),
        'mem': nrm(1, (BATCH, MEM_LEN, D), 1.0),
        'norm_mix': gain(2, (L, D)),
        'w_in': nrm(3, (L, D, IN_W), D ** -0.5),
        'conv_a_w': nrm(4, (L, CONV_K, CONV_W), CONV_K ** -0.5),
        'conv_a_b': nrm(5, (L, CONV_W), 0.02),
        'ln_a_g': gain(6, (L, CONV_W)),
        'ln_a_b': nrm(7, (L, CONV_W), 0.02),
        'dn_conv_w': nrm(8, (L, DN_CONV_K, 3 * MIX_W), DN_CONV_K ** -0.5),
        'dn_a_log': jnp.log(jax.random.uniform(ks[9], (L, DN_HEADS), f32, 1.0, 16.0)),
        'dn_dt_bias': dt + jnp.log(-jnp.expm1(-dt)),
        'dn_norm_g': gain(11, (L, DN_HEAD_DIM)),
        'gm_ln_g': gain(12, (L, GM_W)),
        'gm_ln_b': nrm(13, (L, GM_W), 0.02),
        'gm_ws': nrm(14, (L, GM_GROUPS, GM_CHUNK, GM_CHUNK), GM_CHUNK ** -0.5),
        'gm_bs': gain(15, (L, GM_GROUPS, GM_CHUNK)),
        'pool_w': nrm(16, (L, POOL_GROUPS, POOL_W // POOL_GROUPS, POOL_W // POOL_GROUPS),
                      (POOL_W // POOL_GROUPS) ** -0.5),
        'pool_scale': gain(17, (L, POOL_W)),
        'w_branch': nrm(18, (L, N_BRANCH, MIX_W, D), MIX_W ** -0.5),
        'w_out': nrm(19, (L, D, D), D ** -0.5),
        'norm_xa': gain(20, (L, D)),
        'norm_mem': gain(21, (L, D)),
        'xa_wq': nrm(22, (L, D, D), D ** -0.5),
        'xa_wkv': nrm(23, (L, D, 2 * D), D ** -0.5),
        'xa_wo': nrm(24, (L, D, D), D ** -0.5),
        'norm_mlp': gain(25, (L, D)),
        'mlp_w1': nrm(26, (L, D, FFN_W), D ** -0.5),
        'mlp_w2': nrm(27, (L, FFN_W, D), FFN_W ** -0.5),
        'norm_f': gain(28, (D,)),
    }


def reference(x, mem, norm_mix, w_in, conv_a_w, conv_a_b, ln_a_g, ln_a_b, dn_conv_w, dn_a_log,
              dn_dt_bias, dn_norm_g, gm_ln_g, gm_ln_b, gm_ws, gm_bs, pool_w, pool_scale, w_branch,
              w_out, norm_xa, norm_mem, xa_wq, xa_wkv, xa_wo, norm_mlp, mlp_w1, mlp_w2, norm_f):
    for l in range(DEPTH):
        x = x + hybrid_mixer(rmsnorm(x, norm_mix[l]), w_in[l], conv_a_w[l], conv_a_b[l], ln_a_g[l],
                             ln_a_b[l], dn_conv_w[l], dn_a_log[l], dn_dt_bias[l], dn_norm_g[l],
                             gm_ln_g[l], gm_ln_b[l], gm_ws[l], gm_bs[l], pool_w[l], pool_scale[l],
                             w_branch[l], w_out[l])
        x = x + memory_cross_attention(rmsnorm(x, norm_xa[l]), mem, norm_mem[l], xa_wq[l],
                                       xa_wkv[l], xa_wo[l])
        x = x + squared_relu_mlp(rmsnorm(x, norm_mlp[l]), mlp_w1[l], mlp_w2[l])
    return rmsnorm(x, norm_f)
```

```cpp
#include <hip/hip_runtime.h>
#include <hip/hip_cooperative_groups.h>
#include <cstdio>
namespace cg = cooperative_groups;
namespace pg8 {
#define PG8_LAS __attribute__((address_space(3)))
typedef unsigned short bf16_t;
typedef short bf16x8 __attribute__((ext_vector_type(8)));
typedef float f32x4 __attribute__((ext_vector_type(4)));
typedef unsigned u32x4 __attribute__((ext_vector_type(4)));
constexpr int BM = 256, BK = 64, HALF = 128, HTB = HALF * BK * 2  , STAGE_BYTES = 8 * HTB, NXCD = 8, WGM = 8;

__host__ __device__ __forceinline__ int lds_byte(int r, int c) { const int st = (r >> 4) * 2 + (c >> 5), rr = r & 15, cc = c & 31, ob = rr * 64 + cc * 2; return st * 1024 + (ob ^ (((ob >> 9) & 1) << 5)); }
__host__ __device__ __forceinline__ void stage_rc(int b, int& R, int& C) { const int st = b / 1024, sb = b % 1024, swz = sb ^ (((sb >> 9) & 1) << 5); R = (st >> 1) * 16 + swz / 64; C = (st & 1) * 32 + (swz % 64) / 2; }
__host__ __device__ __forceinline__ int perm32(int rho) { const int n = rho >> 4, i = rho & 15; return 8 * (i >> 2) + 4 * n + (i & 3); }

struct Unit { int pm, pn; };
struct Gemm { const bf16_t* A; const bf16_t* Bt; int M, N, K; };

struct StaticOrder {
    int nM, nN, nwg, G, c;
    __host__ __device__ void init(int M, int N, int G_, int c_) { nM = M / BM; nN = N / BM; nwg = nM * nN; G = G_; c = c_; }
    __host__ __device__ bool next(int i, Unit& u) const {
        const long L = (long)i * G + c; if (L >= nwg) return false;
        int wgid = (int)L; { const int q = nwg / NXCD, r = nwg % NXCD, xcd = wgid % NXCD, off = wgid / NXCD; wgid = (xcd < r ? xcd * (q + 1) : r * (q + 1) + (xcd - r) * q) + off; }
        const int nig = WGM * nN, gid = wgid / nig, fm = gid * WGM, gsz = (nM - fm) < WGM ? (nM - fm) : WGM;
        u.pm = fm + ((wgid % nig) % gsz); u.pn = (wgid % nig) / gsz; return true;
    }
    __device__ __forceinline__ void a_ready(const Unit&) const {}
    __device__ __forceinline__ void done(const Unit&) const {}
};
__device__ __forceinline__ unsigned cvt_pk_bf16(float lo, float hi) { unsigned r; asm("v_cvt_pk_bf16_f32 %0, %1, %2" : "=v"(r) : "v"(lo), "v"(hi)); return r; }
template <class Epi, class Sched, bool STAMP = false>
__device__ __forceinline__ void gemm_phase(PG8_LAS unsigned char* lds, const Gemm g, const Sched& S, const Epi& E, unsigned long long* stamps) {
    int tid_ = threadIdx.x; asm volatile("" : "+v"(tid_)); const int tid = tid_, wid = __builtin_amdgcn_readfirstlane(tid >> 6), lane = tid & 63, wr = wid >> 2, wc = wid & 3, fr = lane & 15, fq = lane >> 4;
    const int K = g.K, nt = K / BK;
    int ts_lo = 0, ts_hi = 0, nts = 0; const unsigned long long rt_entry = STAMP ? (unsigned long long)wall_clock64() : 0ull;
#define PG8_STAMP() do { if (STAMP && wid == 0 && nts < 64) { const unsigned long long _c = (unsigned long long)clock64(); \
        ts_lo = (lane == nts) ? (int)(unsigned)_c : ts_lo; ts_hi = (lane == nts) ? (int)(unsigned)(_c >> 32) : ts_hi; ++nts; } } while (0)
    PG8_STAMP();
    unsigned voffA[2], voffB[2];
#pragma unroll
    for (int i = 0; i < 2; ++i) { int R, C; stage_rc(tid * 16 + i * 8192, R, C); const int Rb = Epi::PERM ? ((R & ~31) + perm32(R & 31)) : R;
        voffA[i] = (unsigned)(R * K + C) * 2u; voffB[i] = (unsigned)(Rb * K + C) * 2u; }
    const size_t kstep = (size_t)(BK * 2);
    const size_t hstep = (size_t)HALF * K * 2;
    const size_t tstep = 2 * hstep;
    const unsigned ldsw = (unsigned)wid * 1024u;
    const int aoff = lds_byte(wr * 64 + fr, fq * 8), boff = lds_byte(wc * 32 + fr, fq * 8);
#define PG8_SA(b, h) (((b) * 2 + (h)) * HTB)
#define PG8_SB(b, h) ((4 + (b) * 2 + (h)) * HTB)
#define PG8_STAGE(bufoff, gbase, voff) do { _Pragma("unroll") for (int _i = 0; _i < 2; ++_i) \
        __builtin_amdgcn_global_load_lds((const unsigned*)((const char*)(gbase) + (voff)[_i]), (PG8_LAS unsigned*)(lds + (bufoff) + ldsw + _i * 8192), 16, 0, 0); } while (0)
#define PG8_LDA(dst, b, h) do { _Pragma("unroll") for (int m = 0; m < 4; ++m) _Pragma("unroll") for (int k = 0; k < 2; ++k) dst[m][k] = *(const PG8_LAS bf16x8*)(lds + PG8_SA(b, h) + aoff + m * 2048 + k * 1024); } while (0)
#define PG8_LDB(dst, b, h) do { _Pragma("unroll") for (int n = 0; n < 2; ++n) _Pragma("unroll") for (int k = 0; k < 2; ++k) dst[n][k] = *(const PG8_LAS bf16x8*)(lds + PG8_SB(b, h) + boff + n * 2048 + k * 1024); } while (0)
#define PG8_MMA(ai, bj, At, Bt) do { __builtin_amdgcn_s_setprio(1); _Pragma("unroll") for (int m = 0; m < 4; ++m) _Pragma("unroll") for (int n = 0; n < 2; ++n) _Pragma("unroll") for (int k = 0; k < 2; ++k) \
        acc[ai][bj][m][n] = __builtin_amdgcn_mfma_f32_16x16x32_bf16(Bt[n][k], At[m][k], acc[ai][bj][m][n], 0, 0, 0); __builtin_amdgcn_s_setprio(0); } while (0)
#define PG8_WAIT_V(n) asm volatile("s_waitcnt vmcnt(" #n ")" ::: "memory")
#define PG8_WAIT_L(n) asm volatile("s_waitcnt lgkmcnt(" #n ")" ::: "memory")
#define PG8_BAR __builtin_amdgcn_s_barrier()
#define PG8_SCHED __builtin_amdgcn_sched_barrier(0)
    Unit cur, nxt; int ui = 0;
    if (!S.next(0, cur)) return;
    f32x4 acc[2][2][4][2];
#pragma unroll
    for (int a = 0; a < 2; ++a)
#pragma unroll
        for (int b = 0; b < 2; ++b)
#pragma unroll
            for (int m = 0; m < 4; ++m)
#pragma unroll
                for (int n = 0; n < 2; ++n) acc[a][b][m][n] = (f32x4){0.f, 0.f, 0.f, 0.f};
    bf16x8 At[4][2], B0[2][2], B1[2][2];
    const char* cA = (const char*)g.A + (size_t)cur.pm * tstep; const char* cB = (const char*)g.Bt + (size_t)cur.pn * tstep;
    S.a_ready(cur);
    PG8_STAGE(PG8_SB(0, 0), cB, voffB); PG8_STAGE(PG8_SA(0, 0), cA, voffA); PG8_STAGE(PG8_SB(0, 1), cB + hstep, voffB); PG8_STAGE(PG8_SA(0, 1), cA + hstep, voffA);
    if (wr == 1) PG8_BAR;
    PG8_WAIT_V(4); PG8_BAR;
    PG8_STAGE(PG8_SB(1, 0), cB + kstep, voffB); PG8_STAGE(PG8_SA(1, 0), cA + kstep, voffA); PG8_STAGE(PG8_SB(1, 1), cB + hstep + kstep, voffB);
    PG8_WAIT_V(6); PG8_BAR;
    PG8_STAMP();
    for (;;) {
        const bool has_next = S.next(ui + 1, nxt);
        const char* nA = has_next ? (const char*)g.A + (size_t)nxt.pm * tstep : cA; const char* nB = has_next ? (const char*)g.Bt + (size_t)nxt.pn * tstep : cB;
        for (int t = 0; t < nt; t += 2) {
            const bool last = (t == nt - 2);
            const char* a1 = cA + (size_t)(t + 1) * kstep;
            const char* a2 = last ? nA : cA + (size_t)(t + 2) * kstep; const char* b2 = last ? nB : cB + (size_t)(t + 2) * kstep;
            const char* a3 = a2 + kstep; const char* b3 = b2 + kstep;
            if (last && has_next) S.a_ready(nxt);
            PG8_LDB(B0, 0, 0); PG8_SCHED; PG8_LDA(At, 0, 0); PG8_STAGE(PG8_SA(1, 1), a1 + hstep, voffA);
            PG8_WAIT_L(8); PG8_BAR; PG8_WAIT_L(0); PG8_MMA(0, 0, At, B0); PG8_BAR; PG8_SCHED;
            PG8_LDB(B1, 0, 1); PG8_STAGE(PG8_SB(0, 0), b2, voffB);
            PG8_BAR; PG8_WAIT_L(0); PG8_MMA(0, 1, At, B1); PG8_BAR;
            PG8_LDA(At, 0, 1); PG8_STAGE(PG8_SA(0, 0), a2, voffA);
            PG8_BAR; PG8_WAIT_L(0); PG8_MMA(1, 0, At, B0); PG8_BAR; PG8_SCHED;
            PG8_STAGE(PG8_SB(0, 1), b2 + hstep, voffB);
            PG8_WAIT_V(6); PG8_BAR; PG8_MMA(1, 1, At, B1); PG8_BAR;
            PG8_LDB(B0, 1, 0); PG8_SCHED; PG8_LDA(At, 1, 0); PG8_STAGE(PG8_SA(0, 1), a2 + hstep, voffA);
            PG8_WAIT_L(8); PG8_BAR; PG8_WAIT_L(0); PG8_MMA(0, 0, At, B0); PG8_BAR; PG8_SCHED;
            PG8_LDB(B1, 1, 1); PG8_STAGE(PG8_SB(1, 0), b3, voffB);
            PG8_BAR; PG8_WAIT_L(0); PG8_MMA(0, 1, At, B1); PG8_BAR;
            PG8_LDA(At, 1, 1); PG8_STAGE(PG8_SA(1, 0), a3, voffA);
            PG8_BAR; PG8_WAIT_L(0); PG8_MMA(1, 0, At, B0); PG8_BAR; PG8_SCHED;
            PG8_STAGE(PG8_SB(1, 1), b3 + hstep, voffB);
            PG8_WAIT_V(6); PG8_BAR; PG8_MMA(1, 1, At, B1); PG8_BAR;
        }
        PG8_STAMP();
        if constexpr (!Epi::AFTER_DRAIN) { E(acc, cur, wr, wc, fr, fq); S.done(cur); }
        PG8_STAMP();
        if (!has_next) break;
#pragma unroll
        for (int a = 0; a < 2; ++a)
#pragma unroll
            for (int b = 0; b < 2; ++b)
#pragma unroll
                for (int m = 0; m < 4; ++m)
#pragma unroll
                    for (int n = 0; n < 2; ++n) acc[a][b][m][n] = (f32x4){0.f, 0.f, 0.f, 0.f};
        cur = nxt; cA = nA; cB = nB; ++ui;
    }
    PG8_WAIT_V(0);
    if (wr == 0) PG8_BAR;
    PG8_BAR;
    if constexpr (Epi::AFTER_DRAIN) { E.fused(acc, cur, wr, wc, fr, fq, lds, wid, lane); S.done(cur); }
    PG8_STAMP();
    if (STAMP && wid == 0) { stamps[lane] = lane < nts ? (((unsigned long long)(unsigned)ts_hi << 32) | (unsigned)ts_lo) : 0ull;
        if (lane == 62) stamps[62] = rt_entry; if (lane == 63) stamps[63] = (unsigned long long)wall_clock64(); }
#undef PG8_STAMP
#undef PG8_SA
#undef PG8_SB
#undef PG8_STAGE
#undef PG8_LDA
#undef PG8_LDB
#undef PG8_MMA
#undef PG8_WAIT_V
#undef PG8_WAIT_L
#undef PG8_BAR
#undef PG8_SCHED
}
}

#include <cstdio>
#include <ctime>
#include <cstdlib>
#include <cstring>
#include <cmath>
#include <vector>
#include <algorithm>
#define CK(x) do { hipError_t e_ = (x); if (e_ != hipSuccess) { fprintf(stderr, "HIP %s:%d %s\n", __FILE__, __LINE__, hipGetErrorString(e_)); exit(2); } } while (0)

typedef unsigned short u16;
typedef pg8::bf16x8 bf16x8;
typedef pg8::f32x4 f32x4;
#define DEVI __device__ __forceinline__
#define MFMA16(a, b, c) __builtin_amdgcn_mfma_f32_16x16x32_bf16((a), (b), (c), 0, 0, 0)

constexpr int T = 16384, DM = 1024, SEQ = 4096, ZW = 8704, INW = 8712, FF = 4096, DEPTH = 4;
constexpr int LDS_BYTES = 147456;

constexpr size_t OFF_WT_IN = 0;
constexpr size_t OFF_WT_BR = OFF_WT_IN + (size_t)ZW * 1024 * 2;
constexpr size_t OFF_WT_OUT = OFF_WT_BR + (size_t)4 * 1024 * 512 * 2;
constexpr size_t OFF_WT_Q = OFF_WT_OUT + (size_t)1024 * 1024 * 2;
constexpr size_t OFF_WT_KV = OFF_WT_Q + (size_t)1024 * 1024 * 2;
constexpr size_t OFF_WT_O = OFF_WT_KV + (size_t)2048 * 1024 * 2;
constexpr size_t OFF_WT_1 = OFF_WT_O + (size_t)1024 * 1024 * 2;
constexpr size_t OFF_WT_2 = OFF_WT_1 + (size_t)4096 * 1024 * 2;
constexpr size_t OFF_POOLT = OFF_WT_2 + (size_t)4096 * 1024 * 2;
constexpr size_t OFF_Z = OFF_POOLT + (size_t)4 * 128 * 128 * 2;
constexpr size_t OFF_HM = OFF_Z + (size_t)T * ZW * 2;
constexpr size_t OFF_BR = OFF_HM + (size_t)T * 1024 * 2;
constexpr size_t OFF_U = OFF_BR + (size_t)4 * T * 512 * 2;
constexpr size_t OFF_W = OFF_U + (size_t)1024 * 64 * 128 * 2;
constexpr size_t OFF_QD = OFF_W + (size_t)1024 * 64 * 128 * 2;
constexpr size_t OFF_KDT = OFF_QD + (size_t)1024 * 64 * 128 * 2;
constexpr size_t OFF_ATT = OFF_KDT + (size_t)1024 * 64 * 128 * 2;
constexpr size_t OFF_GL = OFF_ATT + (size_t)1024 * 64 * 64 * 2;
constexpr size_t OFF_O = OFF_GL + 4096;
constexpr size_t OFF_BD = OFF_O + (size_t)T * 512 * 4;
constexpr size_t OFF_KB = OFF_BD + (size_t)T * 8 * 4;
constexpr size_t OFF_VT = OFF_KB + (size_t)1024 * 1024 * 2;
constexpr size_t OFF_MEMN = OFF_VT + (size_t)1024 * 1024 * 2;
constexpr size_t WS_END = OFF_MEMN + (size_t)1024 * 1024 * 2;
static_assert(WS_END <= (size_t)4 * 4 * 1024 * INW * 4, "workspace too large");
constexpr size_t OFF_Q = OFF_Z;
constexpr size_t OFF_AO = OFF_Z + (size_t)T * 1024 * 2;
constexpr size_t OFF_HID = OFF_Z;

struct Params {
  const float *x, *mem, *norm_mix, *w_in, *conv_a_w, *conv_a_b, *ln_a_g, *ln_a_b, *dn_conv_w, *dn_a_log, *dn_dt_bias, *dn_norm_g,
      *gm_ln_g, *gm_ln_b, *gm_ws, *gm_bs, *pool_w, *pool_scale, *w_branch, *w_out, *norm_xa, *norm_mem, *xa_wq, *xa_wkv, *xa_wo,
      *norm_mlp, *mlp_w1, *mlp_w2, *norm_f;
  float* out;
  unsigned char* ws;
};

DEVI int otid() { int t = threadIdx.x; asm volatile("" : "+v"(t)); return t; }
DEVI float bf2f(u16 b) { return __uint_as_float(((unsigned)b) << 16); }
DEVI float bflo(unsigned u) { return __uint_as_float(u << 16); }
DEVI float bfhi(unsigned u) { return __uint_as_float(u & 0xffff0000u); }
DEVI unsigned pk2(float lo, float hi) { return pg8::cvt_pk_bf16(lo, hi); }
DEVI u16 f2bf(float f) { return (u16)(pk2(f, f) & 0xffffu); }
DEVI void unpack8(uint4 r, float* v) { v[0] = bflo(r.x); v[1] = bfhi(r.x); v[2] = bflo(r.y); v[3] = bfhi(r.y); v[4] = bflo(r.z); v[5] = bfhi(r.z); v[6] = bflo(r.w); v[7] = bfhi(r.w); }
DEVI uint4 pack8(const float* v) { uint4 o; o.x = pk2(v[0], v[1]); o.y = pk2(v[2], v[3]); o.z = pk2(v[4], v[5]); o.w = pk2(v[6], v[7]); return o; }
DEVI bf16x8 as_bf8(uint4 u) { union { uint4 a; bf16x8 b; } c; c.a = u; return c.b; }
DEVI float sigmoidf_(float x) { return 1.f / (1.f + __expf(-x)); }
DEVI float siluf_(float x) { return x / (1.f + __expf(-x)); }
DEVI float geluf_(float x) { return 0.5f * x * (1.f + erff(x * 0.70710678118654752f)); }
DEVI float wave_sum(float v) {
#pragma unroll
  for (int o = 1; o < 64; o <<= 1) v += __shfl_xor(v, o);
  return v;
}
DEVI void lds_wait() { asm volatile("s_waitcnt lgkmcnt(0)" ::: "memory"); }
DEVI void lds_barrier() { asm volatile("s_waitcnt lgkmcnt(0)" ::: "memory"); __builtin_amdgcn_s_barrier(); asm volatile("" ::: "memory"); }

template <int ACT> struct EpiStore {
  static constexpr bool PERM = true, AFTER_DRAIN = false;
  u16* O; int ldc;
  DEVI void operator()(const f32x4 (&acc)[2][2][4][2], const pg8::Unit& u, int wr, int wc, int fr, int fq) const {
    const int row0 = u.pm * 256 + wr * 64 + fr, col0 = u.pn * 256 + wc * 32 + 8 * fq;
#pragma unroll
    for (int ai = 0; ai < 2; ++ai)
#pragma unroll
      for (int m = 0; m < 4; ++m) {
        u16* rowp = O + (size_t)(row0 + ai * 128 + m * 16) * ldc + col0;
#pragma unroll
        for (int bj = 0; bj < 2; ++bj) {
          f32x4 v0 = acc[ai][bj][m][0], v1 = acc[ai][bj][m][1];
          if (ACT == 1) {
#pragma unroll
            for (int e = 0; e < 4; ++e) { float a = fmaxf(v0[e], 0.f), b = fmaxf(v1[e], 0.f); v0[e] = a * a; v1[e] = b * b; }
          }
          uint4 o; o.x = pk2(v0[0], v0[1]); o.y = pk2(v0[2], v0[3]); o.z = pk2(v1[0], v1[1]); o.w = pk2(v1[2], v1[3]);
          *(uint4*)(rowp + bj * 128) = o;
        }
      }
  }
};
struct EpiResid {
  static constexpr bool PERM = false, AFTER_DRAIN = false;
  float* X; int ldc;
  DEVI void operator()(const f32x4 (&acc)[2][2][4][2], const pg8::Unit& u, int wr, int wc, int fr, int fq) const {
    const int row0 = u.pm * 256 + wr * 64 + fr, col0 = u.pn * 256 + wc * 32 + 4 * fq;
#pragma unroll
    for (int ai = 0; ai < 2; ++ai)
#pragma unroll
      for (int m = 0; m < 4; ++m) {
        float* rowp = X + (size_t)(row0 + ai * 128 + m * 16) * ldc + col0;
#pragma unroll
        for (int bj = 0; bj < 2; ++bj)
#pragma unroll
          for (int n = 0; n < 2; ++n) { f32x4* q = (f32x4*)(rowp + bj * 128 + n * 16); *q = *q + acc[ai][bj][m][n]; }
      }
  }
};
template <int FIRST> struct EpiMerge {
  static constexpr bool PERM = true, AFTER_DRAIN = false;
  u16* Mg; const u16* Zg;
  DEVI void operator()(const f32x4 (&acc)[2][2][4][2], const pg8::Unit& u, int wr, int wc, int fr, int fq) const {
    const int row0 = u.pm * 256 + wr * 64 + fr, col0 = u.pn * 256 + wc * 32 + 8 * fq;
#pragma unroll
    for (int ai = 0; ai < 2; ++ai)
#pragma unroll
      for (int m = 0; m < 4; ++m) {
        const size_t row = (size_t)(row0 + ai * 128 + m * 16);
#pragma unroll
        for (int bj = 0; bj < 2; ++bj) {
          const int col = col0 + bj * 128;
          float g[8], o[8];
          unpack8(*(const uint4*)(Zg + row * ZW + col), g);
          if (FIRST) {
#pragma unroll
            for (int e = 0; e < 8; ++e) o[e] = 0.f;
          } else unpack8(*(const uint4*)(Mg + row * 1024 + col), o);
          const f32x4 v0 = acc[ai][bj][m][0], v1 = acc[ai][bj][m][1];
#pragma unroll
          for (int e = 0; e < 4; ++e) { o[e] += sigmoidf_(g[e]) * v0[e]; o[4 + e] += sigmoidf_(g[4 + e]) * v1[e]; }
          *(uint4*)(Mg + row * 1024 + col) = pack8(o);
        }
      }
  }
};
struct EpiKV {
  static constexpr bool PERM = false, AFTER_DRAIN = false;
  u16* Kb; u16* Vt;
  DEVI void operator()(const f32x4 (&acc)[2][2][4][2], const pg8::Unit& u, int wr, int wc, int fr, int fq) const {
    const int row0 = u.pm * 256 + wr * 64 + fr, col0 = u.pn * 256 + wc * 32 + 4 * fq;
#pragma unroll
    for (int ai = 0; ai < 2; ++ai)
#pragma unroll
      for (int m = 0; m < 4; ++m) {
        const int row = row0 + ai * 128 + m * 16;
#pragma unroll
        for (int bj = 0; bj < 2; ++bj)
#pragma unroll
          for (int n = 0; n < 2; ++n) {
            const int col = col0 + bj * 128 + n * 16; const f32x4 v = acc[ai][bj][m][n];
            if (u.pn < 4) { uint2 o; o.x = pk2(v[0], v[1]); o.y = pk2(v[2], v[3]); *(uint2*)(Kb + (size_t)row * 1024 + col) = o; }
            else { const int c2 = col - 1024, hh = c2 >> 8, d = c2 & 255, bb = row >> 8, mm = row & 255;
              u16* vp = Vt + ((size_t)((bb * 4 + hh) * 256 + d)) * 256 + mm;
#pragma unroll
              for (int e = 0; e < 4; ++e) vp[(size_t)e * 256] = f2bf(v[e]); }
          }
      }
  }
};

template <class Epi> DEVI void run_gemm(unsigned char* shm, const u16* A, const u16* Bt, int M, int N, int K, const Epi& E) {
  pg8::StaticOrder S; S.init(M, N, (int)gridDim.x, (int)blockIdx.x);
  pg8::Gemm g; g.A = A; g.Bt = Bt; g.M = M; g.N = N; g.K = K;
  pg8::gemm_phase<Epi, pg8::StaticOrder, false>((PG8_LAS unsigned char*)shm, g, S, E, nullptr);
}

DEVI void transpose_item(const float* W, int srcN, int n0s, int K, u16* WT, int n0d, int k0, float* scr, int lane) {
#pragma unroll 8
  for (int i = 0; i < 32; ++i) { const int kk = 2 * i + (lane >> 5); scr[kk * 33 + (lane & 31)] = W[(size_t)(k0 + kk) * srcN + n0s + (lane & 31)]; }
  lds_wait();
  const int c = lane & 7;
#pragma unroll
  for (int j = 0; j < 4; ++j) { const int n = (lane >> 3) + 8 * j; const float* s = scr + (8 * c) * 33 + n;
    uint4 o; o.x = pk2(s[0 * 33], s[1 * 33]); o.y = pk2(s[2 * 33], s[3 * 33]); o.z = pk2(s[4 * 33], s[5 * 33]); o.w = pk2(s[6 * 33], s[7 * 33]);
    *(uint4*)(WT + (size_t)(n0d + n) * K + k0 + 8 * c) = o; }
  lds_wait();
}

template <bool COPY, bool BDC> DEVI void rms_row(const float* xrow, const float* gain, u16* orow, float* copyrow, const float* wbd, float* bdrow, int lane) {
  const f32x4* xr = (const f32x4*)xrow + lane;
  f32x4 v[4]; float s = 0.f;
#pragma unroll
  for (int j = 0; j < 4; ++j) { v[j] = xr[64 * j]; s += (v[j][0] * v[j][0] + v[j][1] * v[j][1]) + (v[j][2] * v[j][2] + v[j][3] * v[j][3]); }
  if (COPY) {
#pragma unroll
    for (int j = 0; j < 4; ++j) ((f32x4*)copyrow)[lane + 64 * j] = v[j];
  }
  const float rstd = rsqrtf(wave_sum(s) * (1.f / 1024.f) + 1e-6f);
#pragma unroll
  for (int j = 0; j < 4; ++j) { const f32x4 g = ((const f32x4*)gain)[lane + 64 * j]; v[j] = v[j] * rstd * g; }
  uint2* o8 = (uint2*)orow + lane;
#pragma unroll
  for (int j = 0; j < 4; ++j) { uint2 o; o.x = pk2(v[j][0], v[j][1]); o.y = pk2(v[j][2], v[j][3]); o8[64 * j] = o; }
  if (BDC) {
    float a[8];
#pragma unroll
    for (int e = 0; e < 8; ++e) a[e] = 0.f;
#pragma unroll
    for (int j = 0; j < 4; ++j)
#pragma unroll
      for (int q = 0; q < 4; ++q) { const int k = 4 * (lane + 64 * j) + q; const f32x4 w0 = *(const f32x4*)(wbd + (size_t)k * INW), w1 = *(const f32x4*)(wbd + (size_t)k * INW + 4);
        const float hv = v[j][q];
        a[0] += hv * w0[0]; a[1] += hv * w0[1]; a[2] += hv * w0[2]; a[3] += hv * w0[3]; a[4] += hv * w1[0]; a[5] += hv * w1[1]; a[6] += hv * w1[2]; a[7] += hv * w1[3]; }
#pragma unroll
    for (int e = 0; e < 8; ++e) a[e] = wave_sum(a[e]);
    if (lane == 0) { f32x4 o0 = {a[0], a[1], a[2], a[3]}, o1 = {a[4], a[5], a[6], a[7]}; *(f32x4*)bdrow = o0; *(f32x4*)(bdrow + 4) = o1; }
  }
}

DEVI void phase_prep(const Params& p, int l, unsigned char* shm) {
  const int tid = otid(), wid = tid >> 6, lane = tid & 63;
  const int gw = blockIdx.x * 8 + wid, nw = gridDim.x * 8;
  float* scr = (float*)(shm + wid * 8448);
  unsigned char* ws = p.ws;
  const float* w_in = p.w_in + (size_t)l * 1024 * INW;
  for (int it = gw; it < 12064; it += nw) {
    int r = it;
    if (r < 4352) { const int kb = r / 272, n0 = (r % 272) * 32; transpose_item(w_in, INW, n0 + (n0 >= 3072 ? 8 : 0), 1024, (u16*)(ws + OFF_WT_IN), n0, kb * 64, scr, lane); continue; }
    r -= 4352;
    if (r < 1024) { const int i = r >> 8; r &= 255; transpose_item(p.w_branch + ((size_t)l * 4 + i) * 512 * 1024, 1024, (r & 31) * 32, 512, (u16*)(ws + OFF_WT_BR) + (size_t)i * 1024 * 512, (r & 31) * 32, (r >> 5) * 64, scr, lane); continue; }
    r -= 1024;
    if (r < 512) { transpose_item(p.w_out + (size_t)l * 1024 * 1024, 1024, (r & 31) * 32, 1024, (u16*)(ws + OFF_WT_OUT), (r & 31) * 32, (r >> 5) * 64, scr, lane); continue; }
    r -= 512;
    if (r < 512) { transpose_item(p.xa_wq + (size_t)l * 1024 * 1024, 1024, (r & 31) * 32, 1024, (u16*)(ws + OFF_WT_Q), (r & 31) * 32, (r >> 5) * 64, scr, lane); continue; }
    r -= 512;
    if (r < 1024) { transpose_item(p.xa_wkv + (size_t)l * 1024 * 2048, 2048, (r & 63) * 32, 1024, (u16*)(ws + OFF_WT_KV), (r & 63) * 32, (r >> 6) * 64, scr, lane); continue; }
    r -= 1024;
    if (r < 512) { transpose_item(p.xa_wo + (size_t)l * 1024 * 1024, 1024, (r & 31) * 32, 1024, (u16*)(ws + OFF_WT_O), (r & 31) * 32, (r >> 5) * 64, scr, lane); continue; }
    r -= 512;
    if (r < 2048) { transpose_item(p.mlp_w1 + (size_t)l * 1024 * 4096, 4096, (r & 127) * 32, 1024, (u16*)(ws + OFF_WT_1), (r & 127) * 32, (r >> 7) * 64, scr, lane); continue; }
    r -= 2048;
    if (r < 2048) { transpose_item(p.mlp_w2 + (size_t)l * 4096 * 1024, 1024, (r & 31) * 32, 4096, (u16*)(ws + OFF_WT_2), (r & 31) * 32, (r >> 5) * 64, scr, lane); continue; }
    r -= 2048;
    { const int g = r >> 3; r &= 7; transpose_item(p.pool_w + ((size_t)l * 4 + g) * 16384, 128, (r & 3) * 32, 128, (u16*)(ws + OFF_POOLT) + (size_t)g * 16384, (r & 3) * 32, (r >> 2) * 64, scr, lane); }
  }
  const float* wbd = w_in + 3072;
  for (int row = gw; row < T; row += nw) {
    if (l == 0) rms_row<true, true>(p.x + (size_t)row * 1024, p.norm_mix + l * 1024, (u16*)(ws + OFF_HM) + (size_t)row * 1024, p.out + (size_t)row * 1024, wbd, (float*)(ws + OFF_BD) + (size_t)row * 8, lane);
    else rms_row<false, true>(p.out + (size_t)row * 1024, p.norm_mix + l * 1024, (u16*)(ws + OFF_HM) + (size_t)row * 1024, nullptr, wbd, (float*)(ws + OFF_BD) + (size_t)row * 8, lane);
  }
  for (int row = gw; row < 1024; row += nw)
    rms_row<false, false>(p.mem + (size_t)row * 1024, p.norm_mem + l * 1024, (u16*)(ws + OFF_MEMN) + (size_t)row * 1024, nullptr, nullptr, nullptr, lane);
}

DEVI void phase_norm(const Params& p, const float* gain, unsigned char* shm) {
  const int tid = otid(), wid = tid >> 6, lane = tid & 63;
  const int gw = blockIdx.x * 8 + wid, nw = gridDim.x * 8;
  for (int row = gw; row < T; row += nw)
    rms_row<false, false>(p.out + (size_t)row * 1024, gain, (u16*)(p.ws + OFF_HM) + (size_t)row * 1024, nullptr, nullptr, nullptr, lane);
}

DEVI void phase_final(const Params& p) {
  const int tid = otid(), wid = tid >> 6, lane = tid & 63;
  const int gw = blockIdx.x * 8 + wid, nw = gridDim.x * 8;
  for (int row = gw; row < T; row += nw) {
    f32x4* xr = (f32x4*)(p.out + (size_t)row * 1024) + lane;
    f32x4 v[4]; float s = 0.f;
#pragma unroll
    for (int j = 0; j < 4; ++j) { v[j] = xr[64 * j]; s += (v[j][0] * v[j][0] + v[j][1] * v[j][1]) + (v[j][2] * v[j][2] + v[j][3] * v[j][3]); }
    const float rstd = rsqrtf(wave_sum(s) * (1.f / 1024.f) + 1e-6f);
#pragma unroll
    for (int j = 0; j < 4; ++j) { const f32x4 g = ((const f32x4*)p.norm_f)[lane + 64 * j]; xr[64 * j] = v[j] * rstd * g; }
  }
}

DEVI void phase_dn_pre(const Params& p, int l, unsigned char* shm) {
  const int tid = otid(), half = tid >> 8, ht = tid & 255, hw = (tid >> 6) & 3, lane = tid & 63, fr = lane & 15, fq = lane >> 4;
  unsigned char* hb = shm + half * 70400;
  u16* qn = (u16*)hb; u16* kn = qn + 64 * 136; u16* vb = kn + 64 * 136;
  float* Am = (float*)(vb + 64 * 136); float* gam = Am + 64 * 68; float* bet = gam + 64; float* eg = bet + 64;
  unsigned char* ws = p.ws;
  const u16* Z = (const u16*)(ws + OFF_Z);
  const float* cwl = p.dn_conv_w + (size_t)l * 4 * 1536;
  for (int pu = blockIdx.x; pu < 512; pu += gridDim.x) {
    const int cidx = pu >> 1, h = (pu & 1) * 2 + half, b = cidx >> 6, n = cidx & 63;
    const int t0 = b * 4096 + n * 64, ch = cidx * 4 + h;
    {
      const int i = ht >> 2, sub = ht & 3, s = n * 64 + i;
      const u16* zrow = Z + (size_t)(t0 + i) * ZW;
#pragma unroll
      for (int ten = 0; ten < 3; ++ten) {
        const int zc = 1024 + ten * 512 + h * 128 + sub * 32;
        const float* cw = cwl + ten * 512 + h * 128 + sub * 32;
        float val[32]; float ss = 0.f;
#pragma unroll
        for (int c8 = 0; c8 < 4; ++c8) {
          float a[8];
#pragma unroll
          for (int e = 0; e < 8; ++e) a[e] = 0.f;
#pragma unroll
          for (int kk = 0; kk < 4; ++kk) {
            if (s - 3 + kk >= 0) {
              float xv[8]; unpack8(*(const uint4*)(zrow + (ptrdiff_t)(kk - 3) * ZW + zc + c8 * 8), xv);
              const f32x4 w0 = *(const f32x4*)(cw + kk * 1536 + c8 * 8), w1 = *(const f32x4*)(cw + kk * 1536 + c8 * 8 + 4);
#pragma unroll
              for (int e = 0; e < 4; ++e) { a[e] += w0[e] * xv[e]; a[4 + e] += w1[e] * xv[4 + e]; }
            }
          }
#pragma unroll
          for (int e = 0; e < 8; ++e) { const float y = siluf_(a[e]); val[c8 * 8 + e] = y; ss += y * y; }
        }
        if (ten < 2) {
          ss += __shfl_xor(ss, 1); ss += __shfl_xor(ss, 2);
          const float sc = rsqrtf(ss + 1e-6f) * (ten == 0 ? 0.08838834764831845f : 1.f);
#pragma unroll
          for (int e = 0; e < 32; ++e) val[e] *= sc;
        }
        u16* dst = (ten == 0 ? qn : (ten == 1 ? kn : vb)) + i * 136 + sub * 32;
#pragma unroll
        for (int c8 = 0; c8 < 4; ++c8) *(uint4*)(dst + c8 * 8) = pack8(val + c8 * 8);
      }
    }
    if (hw == 0) {
      const float* bd = (const float*)(ws + OFF_BD) + (size_t)(t0 + lane) * 8;
      const float be = sigmoidf_(bd[h]);
      const float xg = bd[4 + h] + p.dn_dt_bias[l * 4 + h];
      const float sp = xg > 20.f ? xg : log1pf(expf(xg));
      float g = -expf(p.dn_a_log[l * 4 + h]) * sp;
#pragma unroll
      for (int o = 1; o < 64; o <<= 1) { const float y = __shfl_up(g, o); if (lane >= o) g += y; }
      gam[lane] = g; bet[lane] = be; eg[lane] = expf(g);
    }
    __syncthreads();
    {
      bf16x8 ak[4], aq[4];
#pragma unroll
      for (int ks = 0; ks < 4; ++ks) { ak[ks] = *(const bf16x8*)(kn + (hw * 16 + fr) * 136 + ks * 32 + fq * 8); aq[ks] = *(const bf16x8*)(qn + (hw * 16 + fr) * 136 + ks * 32 + fq * 8); }
      u16* att = (u16*)(ws + OFF_ATT) + (size_t)ch * 4096;
#pragma unroll
      for (int nt = 0; nt < 4; ++nt) {
        f32x4 ckk = {0.f, 0.f, 0.f, 0.f}, cqk = {0.f, 0.f, 0.f, 0.f};
        if (nt <= hw) {
#pragma unroll
          for (int ks = 0; ks < 4; ++ks) { const bf16x8 bfr = *(const bf16x8*)(kn + (nt * 16 + fr) * 136 + ks * 32 + fq * 8); ckk = MFMA16(ak[ks], bfr, ckk); cqk = MFMA16(aq[ks], bfr, cqk); }
        }
        const int jj = nt * 16 + fr; const float gj = gam[jj];
#pragma unroll
        for (int j = 0; j < 4; ++j) {
          const int i = hw * 16 + fq * 4 + j;
          const float dec = (i >= jj) ? __expf(gam[i] - gj) : 0.f;
          Am[i * 68 + jj] = (i > jj) ? bet[i] * ckk[j] * dec : 0.f;
          att[i * 64 + jj] = f2bf(cqk[j] * dec);
        }
      }
    }
    {
      const int i = ht >> 2, sub = ht & 3; const float egi = eg[i];
      u16* qd = (u16*)(ws + OFF_QD) + ((size_t)ch * 64 + i) * 128 + sub * 32;
#pragma unroll
      for (int c8 = 0; c8 < 4; ++c8) { float v[8]; unpack8(*(const uint4*)(qn + i * 136 + sub * 32 + c8 * 8), v);
#pragma unroll
        for (int e = 0; e < 8; ++e) v[e] *= egi;
        *(uint4*)(qd + c8 * 8) = pack8(v); }
      const int k = ht >> 1, ih = ht & 1; const float gl = gam[63];
      u16* kd = (u16*)(ws + OFF_KDT) + ((size_t)ch * 128 + k) * 64 + ih * 32;
#pragma unroll
      for (int c8 = 0; c8 < 4; ++c8) { float v[8];
#pragma unroll
        for (int e = 0; e < 8; ++e) { const int ii = ih * 32 + c8 * 8 + e; v[e] = bf2f(kn[ii * 136 + k]) * __expf(gl - gam[ii]); }
        *(uint4*)(kd + c8 * 8) = pack8(v); }
      if (ht == 0) ((float*)(ws + OFF_GL))[ch] = eg[63];
    }
    __syncthreads();
    {
      const int col = ht; const bool isw = col >= 128;
      const u16* src = isw ? kn + (col - 128) : vb + col;
      float x[64]; int zo[64];
#pragma unroll
      for (int i = 0; i < 64; ++i) {
        const int zz = (i >= 2) ? zo[i - 2] : 0;
        float r = bf2f(src[i * 136 + zz]) * bet[i + zz]; if (isw) r *= eg[i + zz];
        const float* arow = Am + i * 68 + zz;
#pragma unroll
        for (int j4 = 0; j4 < (i + 3) / 4; ++j4) {
          const f32x4 a = *(const f32x4*)(arow + j4 * 4);
#pragma unroll
          for (int e = 0; e < 4; ++e) if (j4 * 4 + e < i) r -= a[e] * x[j4 * 4 + e];
        }
        x[i] = r;
        asm volatile("v_and_b32 %0, 0, %1" : "=v"(zo[i]) : "v"(__float_as_int(r)));
      }
      u16* dst = (u16*)(ws + (isw ? OFF_W : OFF_U)) + (size_t)ch * 8192 + (col & 127);
#pragma unroll
      for (int i = 0; i < 64; ++i) dst[i * 128] = f2bf(x[i]);
    }
    __syncthreads();
  }
}

DEVI void phase_dn_scan(const Params& p, unsigned char* shm) {
  const int tid = otid(), wid = tid >> 6, lane = tid & 63, fr = lane & 15, fq = lane >> 4;
  const int bid = blockIdx.x, xcd = bid & 7, idx = bid >> 3, stream = xcd * 2 + (idx >> 3), slice = idx & 7;
  const int b = stream >> 2, h = stream & 3, mt = wid & 3; const bool isV = wid < 4;
  unsigned char* ws = p.ws;
  u16* Sb = (u16*)shm; u16* Vb = Sb + 16 * 136;
  const u16* Abase = (const u16*)(ws + (isV ? OFF_W : OFF_QD));
  const u16* KDT = (const u16*)(ws + OFF_KDT); const u16* ATT = (const u16*)(ws + OFF_ATT); const u16* U = (const u16*)(ws + OFF_U);
  const float* GL = (const float*)(ws + OFF_GL); float* O = (float*)(ws + OFF_O);
  f32x4 sacc = {0.f, 0.f, 0.f, 0.f};
  bf16x8 af[4], kf[2], tf[2]; float uu[4]; float gl;
  {
    const int ch = (b * 64 + 0) * 4 + h;
#pragma unroll
    for (int ks = 0; ks < 4; ++ks) af[ks] = *(const bf16x8*)(Abase + ((size_t)ch * 64 + mt * 16 + fr) * 128 + ks * 32 + fq * 8);
#pragma unroll
    for (int ks = 0; ks < 2; ++ks) kf[ks] = *(const bf16x8*)(KDT + ((size_t)ch * 128 + wid * 16 + fr) * 64 + ks * 32 + fq * 8);
    if (isV) {
#pragma unroll
      for (int j = 0; j < 4; ++j) uu[j] = bf2f(U[((size_t)ch * 64 + mt * 16 + fq * 4 + j) * 128 + slice * 16 + fr]);
#pragma unroll
      for (int ks = 0; ks < 2; ++ks) tf[ks] = af[ks];
    } else {
#pragma unroll
      for (int ks = 0; ks < 2; ++ks) tf[ks] = *(const bf16x8*)(ATT + ((size_t)ch * 64 + mt * 16 + fr) * 64 + ks * 32 + fq * 8);
#pragma unroll
      for (int j = 0; j < 4; ++j) uu[j] = 0.f;
    }
    gl = GL[ch];
  }
#pragma unroll 1
  for (int n = 0; n < 64; ++n) {
    const int nn = n < 63 ? n + 1 : 63;
    const int chn = (b * 64 + nn) * 4 + h;
    bf16x8 naf[4], nkf[2], ntf[2]; float nuu[4]; float ngl;
#pragma unroll
    for (int ks = 0; ks < 4; ++ks) naf[ks] = *(const bf16x8*)(Abase + ((size_t)chn * 64 + mt * 16 + fr) * 128 + ks * 32 + fq * 8);
#pragma unroll
    for (int ks = 0; ks < 2; ++ks) nkf[ks] = *(const bf16x8*)(KDT + ((size_t)chn * 128 + wid * 16 + fr) * 64 + ks * 32 + fq * 8);
    if (isV) {
#pragma unroll
      for (int j = 0; j < 4; ++j) nuu[j] = bf2f(U[((size_t)chn * 64 + mt * 16 + fq * 4 + j) * 128 + slice * 16 + fr]);
#pragma unroll
      for (int ks = 0; ks < 2; ++ks) ntf[ks] = naf[ks];
    } else {
#pragma unroll
      for (int ks = 0; ks < 2; ++ks) ntf[ks] = *(const bf16x8*)(ATT + ((size_t)chn * 64 + mt * 16 + fr) * 64 + ks * 32 + fq * 8);
#pragma unroll
      for (int j = 0; j < 4; ++j) nuu[j] = 0.f;
    }
    ngl = GL[chn];
    { uint2 o; o.x = pk2(sacc[0], sacc[1]); o.y = pk2(sacc[2], sacc[3]); *(uint2*)(Sb + fr * 136 + wid * 16 + fq * 4) = o; }
    lds_barrier();
    f32x4 acc = {0.f, 0.f, 0.f, 0.f};
#pragma unroll
    for (int ks = 0; ks < 4; ++ks) { const bf16x8 sf = *(const bf16x8*)(Sb + fr * 136 + ks * 32 + fq * 8); acc = MFMA16(af[ks], sf, acc); }
    if (isV) { uint2 o; o.x = pk2(uu[0] - acc[0], uu[1] - acc[1]); o.y = pk2(uu[2] - acc[2], uu[3] - acc[3]); *(uint2*)(Vb + fr * 72 + mt * 16 + fq * 4) = o; }
    lds_barrier();
    const bf16x8 vf0 = *(const bf16x8*)(Vb + fr * 72 + fq * 8), vf1 = *(const bf16x8*)(Vb + fr * 72 + 32 + fq * 8);
    if (!isV) {
      acc = MFMA16(tf[0], vf0, acc); acc = MFMA16(tf[1], vf1, acc);
      const int t0 = b * 4096 + n * 64;
#pragma unroll
      for (int j = 0; j < 4; ++j) O[(size_t)(t0 + mt * 16 + fq * 4 + j) * 512 + h * 128 + slice * 16 + fr] = acc[j];
    }
    sacc = sacc * gl;
    sacc = MFMA16(kf[0], vf0, sacc); sacc = MFMA16(kf[1], vf1, sacc);
#pragma unroll
    for (int ks = 0; ks < 4; ++ks) af[ks] = naf[ks];
#pragma unroll
    for (int ks = 0; ks < 2; ++ks) { kf[ks] = nkf[ks]; tf[ks] = ntf[ks]; }
#pragma unroll
    for (int j = 0; j < 4; ++j) uu[j] = nuu[j];
    gl = ngl;
  }
}

DEVI void unit_conv(const Params& p, int l, int tile, unsigned char* shm) {
  const int tid = otid(), wid = tid >> 6, lane = tid & 63;
  u16* at = (u16*)shm; float* yt = (float*)(shm + 63488);
  const u16* Z = (const u16*)(p.ws + OFF_Z);
  const int t0 = tile * 32, s0 = t0 & 4095;
  for (int it = tid; it < 62 * 64; it += 512) {
    const int r = it >> 6, c8 = (it & 63) * 8, s = s0 - 30 + r;
    uint4 o = {0u, 0u, 0u, 0u};
    if (s >= 0) { const u16* zr = Z + (size_t)(t0 - 30 + r) * ZW; float a1[8], a2[8]; unpack8(*(const uint4*)(zr + c8), a1); unpack8(*(const uint4*)(zr + 512 + c8), a2);
#pragma unroll
      for (int e = 0; e < 8; ++e) a1[e] *= sigmoidf_(a2[e]);
      o = pack8(a1); }
    *(uint4*)(at + r * 512 + c8) = o;
  }
  __syncthreads();
  {
    const int c = tid; float w[31];
    const float* cw = p.conv_a_w + (size_t)l * 31 * 512 + c;
#pragma unroll
    for (int k = 0; k < 31; ++k) w[k] = cw[k * 512];
    const float bias = p.conv_a_b[l * 512 + c];
    float acc[32];
#pragma unroll
    for (int t = 0; t < 32; ++t) acc[t] = bias;
#pragma unroll
    for (int r = 0; r < 62; ++r) { const float v = bf2f(at[r * 512 + c]);
#pragma unroll
      for (int t = 0; t < 32; ++t) if (r - t >= 0 && r - t <= 30) acc[t] += w[r - t] * v; }
#pragma unroll
    for (int t = 0; t < 32; ++t) yt[t * 512 + c] = acc[t];
  }
  __syncthreads();
  {
    const float* lg = p.ln_a_g + l * 512 + lane * 8; const float* lb = p.ln_a_b + l * 512 + lane * 8;
    u16* out = (u16*)(p.ws + OFF_BR);
#pragma unroll
    for (int tt = 0; tt < 4; ++tt) {
      const int t = wid * 4 + tt;
      const f32x4 v0 = *(const f32x4*)(yt + t * 512 + lane * 8), v1 = *(const f32x4*)(yt + t * 512 + lane * 8 + 4);
      float v[8] = {v0[0], v0[1], v0[2], v0[3], v1[0], v1[1], v1[2], v1[3]};
      float s = 0.f;
#pragma unroll
      for (int e = 0; e < 8; ++e) s += v[e];
      const float mean = wave_sum(s) * (1.f / 512.f); float s2 = 0.f;
#pragma unroll
      for (int e = 0; e < 8; ++e) { v[e] -= mean; s2 += v[e] * v[e]; }
      const float rstd = rsqrtf(wave_sum(s2) * (1.f / 512.f) + 1e-5f);
#pragma unroll
      for (int e = 0; e < 8; ++e) v[e] = siluf_(v[e] * rstd * lg[e] + lb[e]);
      *(uint4*)(out + (size_t)(t0 + t) * 512 + lane * 8) = pack8(v);
    }
  }
  __syncthreads();
}

DEVI void unit_gmlp(const Params& p, int l, int u, unsigned char* shm) {
  const int tid = otid(), wid = tid >> 6, lane = tid & 63, fr = lane & 15, fq = lane >> 4;
  const int chunk = u >> 2, g = u & 3, T0 = chunk * 128;
  u16* vT = (u16*)shm;
  const u16* Z = (const u16*)(p.ws + OFF_Z);
  for (int tt = 0; tt < 16; ++tt) {
    const int tl = wid * 16 + tt;
    float v[8]; unpack8(*(const uint4*)(Z + (size_t)(T0 + tl) * ZW + 3072 + 512 + lane * 8), v);
    float s = 0.f;
#pragma unroll
    for (int e = 0; e < 8; ++e) { v[e] = geluf_(v[e]); s += v[e]; }
    const float mean = wave_sum(s) * (1.f / 512.f); float s2 = 0.f;
#pragma unroll
    for (int e = 0; e < 8; ++e) { v[e] -= mean; s2 += v[e] * v[e]; }
    const float rstd = rsqrtf(wave_sum(s2) * (1.f / 512.f) + 1e-5f);
    if (fq == g) {
      const int cl = fr * 8; const float* lg = p.gm_ln_g + l * 512 + g * 128 + cl; const float* lb = p.gm_ln_b + l * 512 + g * 128 + cl;
#pragma unroll
      for (int e = 0; e < 8; ++e) vT[(cl + e) * 136 + tl] = f2bf(v[e] * rstd * lg[e] + lb[e]);
    }
  }
  __syncthreads();
  f32x4 acc[8];
#pragma unroll
  for (int nt = 0; nt < 8; ++nt) acc[nt] = (f32x4){0.f, 0.f, 0.f, 0.f};
  const float* Wg = p.gm_ws + ((size_t)l * 4 + g) * 16384;
#pragma unroll
  for (int ks = 0; ks < 4; ++ks) {
    if (ks * 32 <= wid * 16 + 15) {
      const int t = wid * 16 + fr, sb = ks * 32 + fq * 8;
      const f32x4 w0 = *(const f32x4*)(Wg + t * 128 + sb), w1 = *(const f32x4*)(Wg + t * 128 + sb + 4);
      float wv[8] = {w0[0], w0[1], w0[2], w0[3], w1[0], w1[1], w1[2], w1[3]};
#pragma unroll
      for (int e = 0; e < 8; ++e) if (sb + e > t) wv[e] = 0.f;
      const bf16x8 afr = as_bf8(pack8(wv));
#pragma unroll
      for (int nt = 0; nt < 8; ++nt) { const bf16x8 bfr = *(const bf16x8*)(vT + (nt * 16 + fr) * 136 + ks * 32 + fq * 8); acc[nt] = MFMA16(afr, bfr, acc[nt]); }
    }
  }
  u16* out = (u16*)(p.ws + OFF_BR) + (size_t)2 * T * 512;
#pragma unroll
  for (int j = 0; j < 4; ++j) {
    const int tl = wid * 16 + fq * 4 + j; const float bs = p.gm_bs[(l * 4 + g) * 128 + tl];
#pragma unroll
    for (int nt = 0; nt < 8; ++nt) {
      const int c = nt * 16 + fr;
      const float uu = geluf_(bf2f(Z[(size_t)(T0 + tl) * ZW + 3072 + g * 128 + c]));
      out[(size_t)(T0 + tl) * 512 + g * 128 + c] = f2bf(uu * (acc[nt][j] + bs));
    }
  }
  __syncthreads();
}

DEVI void unit_pool(const Params& p, int l, int u, unsigned char* shm) {
  const int tid = otid(), wid = tid >> 6, lane = tid & 63, fr = lane & 15, fq = lane >> 4;
  const int tile = u >> 2, gi = u & 3, win = 2 << gi, T0 = tile * 128, s0 = T0 & 4095;
  float* xs = (float*)shm; u16* pA = (u16*)(shm + 143 * 128 * 4);
  const u16* Z = (const u16*)(p.ws + OFF_Z);
  for (int it = tid; it < 143 * 16; it += 512) {
    const int r = it >> 4, c8 = (it & 15) * 8, s = s0 - 15 + r;
    float v[8];
#pragma unroll
    for (int e = 0; e < 8; ++e) v[e] = 0.f;
    if (s >= 0) unpack8(*(const uint4*)(Z + (size_t)(T0 - 15 + r) * ZW + 4096 + gi * 128 + c8), v);
    *(f32x4*)(xs + r * 128 + c8) = (f32x4){v[0], v[1], v[2], v[3]}; *(f32x4*)(xs + r * 128 + c8 + 4) = (f32x4){v[4], v[5], v[6], v[7]};
  }
  __syncthreads();
  {
    const int c = tid & 127, tstart = (tid >> 7) * 32;
    float S = 0.f;
    for (int k = 0; k < win; ++k) S += xs[(tstart + 15 - k) * 128 + c];
    for (int tt = 0; tt < 32; ++tt) {
      const int tl = tstart + tt;
      if (tt > 0) S += xs[(tl + 15) * 128 + c] - xs[(tl + 15 - win) * 128 + c];
      const int s = s0 + tl; const float cnt = (float)(s + 1 < win ? s + 1 : win);
      pA[tl * 136 + c] = f2bf(S / cnt - xs[(tl + 15) * 128 + c]);
    }
  }
  __syncthreads();
  f32x4 acc[8];
#pragma unroll
  for (int nt = 0; nt < 8; ++nt) acc[nt] = (f32x4){0.f, 0.f, 0.f, 0.f};
  const u16* Bt = (const u16*)(p.ws + OFF_POOLT) + (size_t)gi * 16384;
#pragma unroll
  for (int ks = 0; ks < 4; ++ks) {
    const bf16x8 afr = *(const bf16x8*)(pA + (wid * 16 + fr) * 136 + ks * 32 + fq * 8);
#pragma unroll
    for (int nt = 0; nt < 8; ++nt) { const bf16x8 bfr = *(const bf16x8*)(Bt + (nt * 16 + fr) * 128 + ks * 32 + fq * 8); acc[nt] = MFMA16(afr, bfr, acc[nt]); }
  }
  u16* out = (u16*)(p.ws + OFF_BR) + (size_t)3 * T * 512;
#pragma unroll
  for (int nt = 0; nt < 8; ++nt) {
    const int d = nt * 16 + fr; const float sc = p.pool_scale[l * 512 + gi * 128 + d];
#pragma unroll
    for (int j = 0; j < 4; ++j) { const int tl = wid * 16 + fq * 4 + j; out[(size_t)(T0 + tl) * 512 + gi * 128 + d] = f2bf(acc[nt][j] * sc); }
  }
  __syncthreads();
}

DEVI void phase_dn_post(const Params& p, int l) {
  const int tid = otid(), wid = tid >> 6, lane = tid & 63;
  const int gw = blockIdx.x * 8 + wid, nw = gridDim.x * 8;
  const float* O = (const float*)(p.ws + OFF_O); const u16* Z = (const u16*)(p.ws + OFF_Z);
  u16* out = (u16*)(p.ws + OFF_BR) + (size_t)1 * T * 512;
  const float* ng = p.dn_norm_g + l * 128 + (lane & 15) * 8;
  for (int row = gw; row < T; row += nw) {
    const f32x4 a = *(const f32x4*)(O + (size_t)row * 512 + lane * 8), b2 = *(const f32x4*)(O + (size_t)row * 512 + lane * 8 + 4);
    float v[8] = {a[0], a[1], a[2], a[3], b2[0], b2[1], b2[2], b2[3]};
    float ss = 0.f;
#pragma unroll
    for (int e = 0; e < 8; ++e) ss += v[e] * v[e];
    ss += __shfl_xor(ss, 1); ss += __shfl_xor(ss, 2); ss += __shfl_xor(ss, 4); ss += __shfl_xor(ss, 8);
    const float rs = rsqrtf(ss * (1.f / 128.f) + 1e-6f);
    float gt[8]; unpack8(*(const uint4*)(Z + (size_t)row * ZW + 2560 + lane * 8), gt);
#pragma unroll
    for (int e = 0; e < 8; ++e) v[e] = v[e] * rs * ng[e] * siluf_(gt[e]);
    *(uint4*)(out + (size_t)row * 512 + lane * 8) = pack8(v);
  }
}

DEVI void phase_attn(const Params& p) {
  const int tid = otid(), wid = tid >> 6, lane = tid & 63, fr = lane & 15, fq = lane >> 4;
  const u16* Q = (const u16*)(p.ws + OFF_Q); const u16* KB = (const u16*)(p.ws + OFF_KB); const u16* VT = (const u16*)(p.ws + OFF_VT);
  u16* AO = (u16*)(p.ws + OFF_AO);
  for (int u = blockIdx.x; u < 512; u += gridDim.x) {
    const int qt = u & 31, head = (u >> 5) & 3, b = u >> 7;
    const int q0 = b * 4096 + qt * 128 + wid * 16;
    const u16* Qp = Q + (size_t)(q0 + fr) * 1024 + head * 256 + fq * 8;
    bf16x8 qf[8];
#pragma unroll
    for (int kk = 0; kk < 8; ++kk) qf[kk] = *(const bf16x8*)(Qp + kk * 32);
    const u16* Kp = KB + (size_t)(b * 256 + fr) * 1024 + head * 256 + fq * 8;
    f32x4 sc[16];
#pragma unroll
    for (int mt = 0; mt < 16; ++mt) {
      f32x4 a = {0.f, 0.f, 0.f, 0.f};
#pragma unroll
      for (int kk = 0; kk < 8; ++kk) { const bf16x8 kfr = *(const bf16x8*)(Kp + (size_t)mt * 16 * 1024 + kk * 32); a = MFMA16(kfr, qf[kk], a); }
      sc[mt] = a;
    }
    float mx = -3.0e38f;
#pragma unroll
    for (int mt = 0; mt < 16; ++mt)
#pragma unroll
      for (int j = 0; j < 4; ++j) mx = fmaxf(mx, sc[mt][j]);
    mx = fmaxf(mx, __shfl_xor(mx, 16)); mx = fmaxf(mx, __shfl_xor(mx, 32));
    float sum = 0.f;
#pragma unroll
    for (int mt = 0; mt < 16; ++mt)
#pragma unroll
      for (int j = 0; j < 4; ++j) { const float e = exp2f((sc[mt][j] - mx) * (1.4426950408889634f / 16.f)); sum += e; sc[mt][j] = e; }
    sum += __shfl_xor(sum, 16); sum += __shfl_xor(sum, 32);
    const float inv = 1.f / sum;
    bf16x8 pf[8];
#pragma unroll
    for (int t2 = 0; t2 < 8; ++t2) { uint4 o; o.x = pk2(sc[2 * t2][0], sc[2 * t2][1]); o.y = pk2(sc[2 * t2][2], sc[2 * t2][3]); o.z = pk2(sc[2 * t2 + 1][0], sc[2 * t2 + 1][1]); o.w = pk2(sc[2 * t2 + 1][2], sc[2 * t2 + 1][3]); pf[t2] = as_bf8(o); }
    const u16* Vp = VT + ((size_t)(b * 4 + head) * 256 + fr) * 256 + fq * 4;
    u16* op = AO + (size_t)(q0 + fr) * 1024 + head * 256 + fq * 4;
#pragma unroll
    for (int dt = 0; dt < 16; ++dt) {
      f32x4 o = {0.f, 0.f, 0.f, 0.f};
#pragma unroll
      for (int t2 = 0; t2 < 8; ++t2) { const uint2 lo = *(const uint2*)(Vp + (size_t)dt * 16 * 256 + t2 * 32), hi = *(const uint2*)(Vp + (size_t)dt * 16 * 256 + t2 * 32 + 16);
        uint4 vv; vv.x = lo.x; vv.y = lo.y; vv.z = hi.x; vv.w = hi.y; o = MFMA16(as_bf8(vv), pf[t2], o); }
      uint2 st; st.x = pk2(o[0] * inv, o[1] * inv); st.y = pk2(o[2] * inv, o[3] * inv);
      *(uint2*)(op + dt * 16) = st;
    }
  }
}

__global__ void __launch_bounds__(512, 2) mega(Params p) {
  extern __shared__ __attribute__((aligned(16))) unsigned char shm[];
  cg::grid_group grid = cg::this_grid();
  unsigned char* ws = p.ws;
  const int bid = blockIdx.x, G = gridDim.x;
#pragma unroll 1
  for (int l = 0; l < DEPTH; ++l) {
    phase_prep(p, l, shm);
    grid.sync();
    { EpiStore<0> E; E.O = (u16*)(ws + OFF_Z); E.ldc = ZW; run_gemm(shm, (const u16*)(ws + OFF_HM), (const u16*)(ws + OFF_WT_IN), T, ZW, 1024, E); }
    grid.sync();
    phase_dn_pre(p, l, shm);
    grid.sync();
    if (bid < 128) phase_dn_scan(p, shm);
    else {
      for (int u = bid - 128; u < 1536; u += G - 128) {
        const int ty = u >> 9, ix = u & 511;
        if (ty == 0) unit_conv(p, l, ix, shm); else if (ty == 1) unit_gmlp(p, l, ix, shm); else unit_pool(p, l, ix, shm);
      }
    }
    grid.sync();
    phase_dn_post(p, l);
    { EpiKV E; E.Kb = (u16*)(ws + OFF_KB); E.Vt = (u16*)(ws + OFF_VT); run_gemm(shm, (const u16*)(ws + OFF_MEMN), (const u16*)(ws + OFF_WT_KV), 1024, 2048, 1024, E); }
    grid.sync();
    { EpiMerge<1> E; E.Mg = (u16*)(ws + OFF_HM); E.Zg = (const u16*)(ws + OFF_Z) + 4608; run_gemm(shm, (const u16*)(ws + OFF_BR), (const u16*)(ws + OFF_WT_BR), T, 1024, 512, E); }
#pragma unroll 1
    for (int i = 1; i < 4; ++i) { EpiMerge<0> E; E.Mg = (u16*)(ws + OFF_HM); E.Zg = (const u16*)(ws + OFF_Z) + 4608 + i * 1024;
      run_gemm(shm, (const u16*)(ws + OFF_BR) + (size_t)i * T * 512, (const u16*)(ws + OFF_WT_BR) + (size_t)i * 1024 * 512, T, 1024, 512, E); }
    grid.sync();
    { EpiResid E; E.X = p.out; E.ldc = 1024; run_gemm(shm, (const u16*)(ws + OFF_HM), (const u16*)(ws + OFF_WT_OUT), T, 1024, 1024, E); }
    grid.sync();
    phase_norm(p, p.norm_xa + l * 1024, shm);
    grid.sync();
    { EpiStore<0> E; E.O = (u16*)(ws + OFF_Q); E.ldc = 1024; run_gemm(shm, (const u16*)(ws + OFF_HM), (const u16*)(ws + OFF_WT_Q), T, 1024, 1024, E); }
    grid.sync();
    phase_attn(p);
    grid.sync();
    { EpiResid E; E.X = p.out; E.ldc = 1024; run_gemm(shm, (const u16*)(ws + OFF_AO), (const u16*)(ws + OFF_WT_O), T, 1024, 1024, E); }
    grid.sync();
    phase_norm(p, p.norm_mlp + l * 1024, shm);
    grid.sync();
    { EpiStore<1> E; E.O = (u16*)(ws + OFF_HID); E.ldc = FF; run_gemm(shm, (const u16*)(ws + OFF_HM), (const u16*)(ws + OFF_WT_1), T, FF, 1024, E); }
    grid.sync();
    { EpiResid E; E.X = p.out; E.ldc = 1024; run_gemm(shm, (const u16*)(ws + OFF_HID), (const u16*)(ws + OFF_WT_2), T, 1024, FF, E); }
    grid.sync();
  }
  phase_final(p);
}

extern "C" void kernel_launch(void* const* d_in, const int* in_sizes, int n_in, void* d_out, int out_size,
                              void* d_ws, size_t ws_size, hipStream_t stream) {
  static int grid_blocks = 0;
  if (!grid_blocks) {
    int dev = 0, cus = 0, per_cu = 0;
    (void)hipGetDevice(&dev);
    (void)hipDeviceGetAttribute(&cus, hipDeviceAttributeMultiprocessorCount, dev);
    (void)hipFuncSetAttribute((const void*)mega, hipFuncAttributeMaxDynamicSharedMemorySize, LDS_BYTES);
    (void)hipOccupancyMaxActiveBlocksPerMultiprocessor(&per_cu, (const void*)mega, 512, (size_t)LDS_BYTES);
    if (n_in != 29 || ws_size < WS_END || per_cu < 1 || cus < 136) fprintf(stderr, "kernel_launch: unexpected configuration n_in %d ws %zu (need %zu) per_cu %d cus %d\n", n_in, ws_size, (size_t)WS_END, per_cu, cus);
    grid_blocks = cus > 256 ? 256 : cus;
  }
  Params p{};
  const float** pp = (const float**)&p;
  for (int i = 0; i < 29; ++i) pp[i] = (const float*)d_in[i];
  p.out = (float*)d_out; p.ws = (unsigned char*)d_ws;
  void* args[] = {&p};
  hipError_t e = hipLaunchCooperativeKernel((void*)mega, dim3(grid_blocks), dim3(512), args, (size_t)LDS_BYTES, stream);
  if (e != hipSuccess) fprintf(stderr, "cooperative launch failed: %s (grid %d)\n", hipGetErrorString(e), grid_blocks);
}
```

```cpp
#include <hip/hip_runtime.h>
#include <hip/hip_cooperative_groups.h>
#include <cstdio>
namespace cg = cooperative_groups;
namespace pg8 {
#define PG8_LAS __attribute__((address_space(3)))
typedef unsigned short bf16_t;
typedef short bf16x8 __attribute__((ext_vector_type(8)));
typedef float f32x4 __attribute__((ext_vector_type(4)));
typedef unsigned u32x4 __attribute__((ext_vector_type(4)));
constexpr int BM = 256, BK = 64, HALF = 128, HTB = HALF * BK * 2  , STAGE_BYTES = 8 * HTB, NXCD = 8, WGM = 8;

__host__ __device__ __forceinline__ int lds_byte(int r, int c) { const int st = (r >> 4) * 2 + (c >> 5), rr = r & 15, cc = c & 31, ob = rr * 64 + cc * 2; return st * 1024 + (ob ^ (((ob >> 9) & 1) << 5)); }
__host__ __device__ __forceinline__ void stage_rc(int b, int& R, int& C) { const int st = b / 1024, sb = b % 1024, swz = sb ^ (((sb >> 9) & 1) << 5); R = (st >> 1) * 16 + swz / 64; C = (st & 1) * 32 + (swz % 64) / 2; }
__host__ __device__ __forceinline__ int perm32(int rho) { const int n = rho >> 4, i = rho & 15; return 8 * (i >> 2) + 4 * n + (i & 3); }

struct Unit { int pm, pn; };
struct Gemm { const bf16_t* A; const bf16_t* Bt; int M, N, K; };

struct StaticOrder {
    int nM, nN, nwg, G, c;
    __host__ __device__ void init(int M, int N, int G_, int c_) { nM = M / BM; nN = N / BM; nwg = nM * nN; G = G_; c = c_; }
    __host__ __device__ bool next(int i, Unit& u) const {
        const long L = (long)i * G + c; if (L >= nwg) return false;
        int wgid = (int)L; { const int q = nwg / NXCD, r = nwg % NXCD, xcd = wgid % NXCD, off = wgid / NXCD; wgid = (xcd < r ? xcd * (q + 1) : r * (q + 1) + (xcd - r) * q) + off; }
        const int nig = WGM * nN, gid = wgid / nig, fm = gid * WGM, gsz = (nM - fm) < WGM ? (nM - fm) : WGM;
        u.pm = fm + ((wgid % nig) % gsz); u.pn = (wgid % nig) / gsz; return true;
    }
    __device__ __forceinline__ void a_ready(const Unit&) const {}
    __device__ __forceinline__ void done(const Unit&) const {}
};
__device__ __forceinline__ unsigned cvt_pk_bf16(float lo, float hi) { unsigned r; asm("v_cvt_pk_bf16_f32 %0, %1, %2" : "=v"(r) : "v"(lo), "v"(hi)); return r; }
template <class Epi, class Sched, bool STAMP = false>
__device__ __forceinline__ void gemm_phase(PG8_LAS unsigned char* lds, const Gemm g, const Sched& S, const Epi& E, unsigned long long* stamps, int wv_) {
    int tid_ = (wv_ << 6) | (int)__builtin_amdgcn_mbcnt_hi(~0u, __builtin_amdgcn_mbcnt_lo(~0u, 0u)); asm volatile("" : "+v"(tid_)); const int tid = tid_, wid = __builtin_amdgcn_readfirstlane(tid >> 6), lane = tid & 63, wr = wid >> 2, wc = wid & 3, fr = lane & 15, fq = lane >> 4;
    const int K = g.K, nt = K / BK;
    int ts_lo = 0, ts_hi = 0, nts = 0; const unsigned long long rt_entry = STAMP ? (unsigned long long)wall_clock64() : 0ull;
#define PG8_STAMP() do { if (STAMP && wid == 0 && nts < 64) { const unsigned long long _c = (unsigned long long)clock64(); \
        ts_lo = (lane == nts) ? (int)(unsigned)_c : ts_lo; ts_hi = (lane == nts) ? (int)(unsigned)(_c >> 32) : ts_hi; ++nts; } } while (0)
    PG8_STAMP();
    unsigned voffA[2], voffB[2];
#pragma unroll
    for (int i = 0; i < 2; ++i) { int R, C; stage_rc(tid * 16 + i * 8192, R, C); const int Rb = Epi::PERM ? ((R & ~31) + perm32(R & 31)) : R;
        voffA[i] = (unsigned)(R * K + C) * 2u; voffB[i] = (unsigned)(Rb * K + C) * 2u; }
    const size_t kstep = (size_t)(BK * 2);
    const size_t hstep = (size_t)HALF * K * 2;
    const size_t tstep = 2 * hstep;
    const unsigned ldsw = (unsigned)wid * 1024u;
    const int aoff = lds_byte(wr * 64 + fr, fq * 8), boff = lds_byte(wc * 32 + fr, fq * 8);
#define PG8_SA(b, h) (((b) * 2 + (h)) * HTB)
#define PG8_SB(b, h) ((4 + (b) * 2 + (h)) * HTB)
#define PG8_STAGE(bufoff, gbase, voff) do { _Pragma("unroll") for (int _i = 0; _i < 2; ++_i) \
        __builtin_amdgcn_global_load_lds((const unsigned*)((const char*)(gbase) + (voff)[_i]), (PG8_LAS unsigned*)(lds + (bufoff) + ldsw + _i * 8192), 16, 0, 0); } while (0)
#define PG8_LDA(dst, b, h) do { _Pragma("unroll") for (int m = 0; m < 4; ++m) _Pragma("unroll") for (int k = 0; k < 2; ++k) dst[m][k] = *(const PG8_LAS bf16x8*)(lds + PG8_SA(b, h) + aoff + m * 2048 + k * 1024); } while (0)
#define PG8_LDB(dst, b, h) do { _Pragma("unroll") for (int n = 0; n < 2; ++n) _Pragma("unroll") for (int k = 0; k < 2; ++k) dst[n][k] = *(const PG8_LAS bf16x8*)(lds + PG8_SB(b, h) + boff + n * 2048 + k * 1024); } while (0)
#define PG8_MMA(ai, bj, At, Bt) do { __builtin_amdgcn_s_setprio(1); _Pragma("unroll") for (int m = 0; m < 4; ++m) _Pragma("unroll") for (int n = 0; n < 2; ++n) _Pragma("unroll") for (int k = 0; k < 2; ++k) \
        acc[ai][bj][m][n] = __builtin_amdgcn_mfma_f32_16x16x32_bf16(Bt[n][k], At[m][k], acc[ai][bj][m][n], 0, 0, 0); __builtin_amdgcn_s_setprio(0); } while (0)
#define PG8_WAIT_V(n) asm volatile("s_waitcnt vmcnt(" #n ")" ::: "memory")
#define PG8_WAIT_L(n) asm volatile("s_waitcnt lgkmcnt(" #n ")" ::: "memory")
#define PG8_BAR __builtin_amdgcn_s_barrier()
#define PG8_SCHED __builtin_amdgcn_sched_barrier(0)
    Unit cur, nxt; int ui = 0;
    if (!S.next(0, cur)) return;
    f32x4 acc[2][2][4][2];
    E.init(acc, cur, wr, wc, fr, fq);
    bf16x8 At[4][2], B0[2][2], B1[2][2];
    const char* cA = (const char*)g.A + (size_t)cur.pm * tstep; const char* cB = (const char*)g.Bt + (size_t)cur.pn * tstep;
    S.a_ready(cur);
    PG8_STAGE(PG8_SB(0, 0), cB, voffB); PG8_STAGE(PG8_SA(0, 0), cA, voffA); PG8_STAGE(PG8_SB(0, 1), cB + hstep, voffB); PG8_STAGE(PG8_SA(0, 1), cA + hstep, voffA);
    if (wr == 1) PG8_BAR;
    PG8_WAIT_V(4); PG8_BAR;
    PG8_STAGE(PG8_SB(1, 0), cB + kstep, voffB); PG8_STAGE(PG8_SA(1, 0), cA + kstep, voffA); PG8_STAGE(PG8_SB(1, 1), cB + hstep + kstep, voffB);
    PG8_WAIT_V(6); PG8_BAR;
    PG8_STAMP();
    for (;;) {
        const bool has_next = S.next(ui + 1, nxt);
        const char* nA = has_next ? (const char*)g.A + (size_t)nxt.pm * tstep : cA; const char* nB = has_next ? (const char*)g.Bt + (size_t)nxt.pn * tstep : cB;
        for (int t = 0; t < nt; t += 2) {
            const bool last = (t == nt - 2);
            const char* a1 = cA + (size_t)(t + 1) * kstep;
            const char* a2 = last ? nA : cA + (size_t)(t + 2) * kstep; const char* b2 = last ? nB : cB + (size_t)(t + 2) * kstep;
            const char* a3 = a2 + kstep; const char* b3 = b2 + kstep;
            if (last && has_next) S.a_ready(nxt);
            PG8_LDB(B0, 0, 0); PG8_SCHED; PG8_LDA(At, 0, 0); PG8_STAGE(PG8_SA(1, 1), a1 + hstep, voffA);
            PG8_WAIT_L(8); PG8_BAR; PG8_WAIT_L(0); PG8_MMA(0, 0, At, B0); PG8_BAR; PG8_SCHED;
            PG8_LDB(B1, 0, 1); PG8_STAGE(PG8_SB(0, 0), b2, voffB);
            PG8_BAR; PG8_WAIT_L(0); PG8_MMA(0, 1, At, B1); PG8_BAR;
            PG8_LDA(At, 0, 1); PG8_STAGE(PG8_SA(0, 0), a2, voffA);
            PG8_BAR; PG8_WAIT_L(0); PG8_MMA(1, 0, At, B0); PG8_BAR; PG8_SCHED;
            PG8_STAGE(PG8_SB(0, 1), b2 + hstep, voffB);
            PG8_WAIT_V(6); PG8_BAR; PG8_MMA(1, 1, At, B1); PG8_BAR;
            PG8_LDB(B0, 1, 0); PG8_SCHED; PG8_LDA(At, 1, 0); PG8_STAGE(PG8_SA(0, 1), a2 + hstep, voffA);
            PG8_WAIT_L(8); PG8_BAR; PG8_WAIT_L(0); PG8_MMA(0, 0, At, B0); PG8_BAR; PG8_SCHED;
            PG8_LDB(B1, 1, 1); PG8_STAGE(PG8_SB(1, 0), b3, voffB);
            PG8_BAR; PG8_WAIT_L(0); PG8_MMA(0, 1, At, B1); PG8_BAR;
            PG8_LDA(At, 1, 1); PG8_STAGE(PG8_SA(1, 0), a3, voffA);
            PG8_BAR; PG8_WAIT_L(0); PG8_MMA(1, 0, At, B0); PG8_BAR; PG8_SCHED;
            PG8_STAGE(PG8_SB(1, 1), b3 + hstep, voffB);
            PG8_WAIT_V(6); PG8_BAR; PG8_MMA(1, 1, At, B1); PG8_BAR;
        }
        PG8_STAMP();
        if constexpr (!Epi::AFTER_DRAIN) { E(acc, cur, wr, wc, fr, fq); S.done(cur); }
        PG8_STAMP();
        if (!has_next) break;
        cur = nxt; cA = nA; cB = nB; ++ui;
        E.init(acc, cur, wr, wc, fr, fq);
    }
    PG8_WAIT_V(0);
    if (wr == 0) PG8_BAR;
    PG8_BAR;
    if constexpr (Epi::AFTER_DRAIN) { E.fused(acc, cur, wr, wc, fr, fq, lds, wid, lane); S.done(cur); }
    PG8_STAMP();
    if (STAMP && wid == 0) { stamps[lane] = lane < nts ? (((unsigned long long)(unsigned)ts_hi << 32) | (unsigned)ts_lo) : 0ull;
        if (lane == 62) stamps[62] = rt_entry; if (lane == 63) stamps[63] = (unsigned long long)wall_clock64(); }
#undef PG8_STAMP
#undef PG8_SA
#undef PG8_SB
#undef PG8_STAGE
#undef PG8_LDA
#undef PG8_LDB
#undef PG8_MMA
#undef PG8_WAIT_V
#undef PG8_WAIT_L
#undef PG8_BAR
#undef PG8_SCHED
}
}

#include <cstdio>
#include <ctime>
#include <cstdlib>
#include <cstring>
#include <cmath>
#include <vector>
#include <algorithm>
#define CK(x) do { hipError_t e_ = (x); if (e_ != hipSuccess) { fprintf(stderr, "HIP %s:%d %s\n", __FILE__, __LINE__, hipGetErrorString(e_)); exit(2); } } while (0)


typedef unsigned short u16;
typedef pg8::bf16x8 bf16x8;
typedef pg8::f32x4 f32x4;
#define DEVI __device__ __forceinline__
#define MFMA16(a, b, c) __builtin_amdgcn_mfma_f32_16x16x32_bf16((a), (b), (c), 0, 0, 0)

constexpr int T = 16384, DM = 1024, SEQ = 4096, ZW = 8960, INW = 8712, FF = 4096, DEPTH = 4;
constexpr int LDS_BYTES = 147456;

constexpr size_t OFF_WT_IN = 0;
constexpr size_t OFF_WT_BR = OFF_WT_IN + (size_t)ZW * 1024 * 2;
constexpr size_t OFF_WT_OUT = OFF_WT_BR + (size_t)4 * 1024 * 512 * 2;
constexpr size_t OFF_WT_Q = OFF_WT_OUT + (size_t)1024 * 1024 * 2;
constexpr size_t OFF_WT_KV = OFF_WT_Q + (size_t)1024 * 1024 * 2;
constexpr size_t OFF_WT_O = OFF_WT_KV + (size_t)2048 * 1024 * 2;
constexpr size_t OFF_WT_1 = OFF_WT_O + (size_t)1024 * 1024 * 2;
constexpr size_t OFF_WT_2 = OFF_WT_1 + (size_t)4096 * 1024 * 2;
constexpr size_t OFF_POOLT = OFF_WT_2 + (size_t)4096 * 1024 * 2;
constexpr size_t OFF_Z = OFF_POOLT + (size_t)4 * 128 * 128 * 2;
constexpr size_t OFF_HM = OFF_Z + (size_t)T * ZW * 2;
constexpr size_t OFF_BR = OFF_HM + (size_t)T * 1024 * 2;
constexpr size_t OFF_U = OFF_BR + (size_t)4 * T * 512 * 2;
constexpr size_t OFF_W = OFF_U + (size_t)1024 * 64 * 128 * 2;
constexpr size_t OFF_QD = OFF_W + (size_t)1024 * 64 * 128 * 2;
constexpr size_t OFF_KDT = OFF_QD + (size_t)1024 * 64 * 128 * 2;
constexpr size_t OFF_ATT = OFF_KDT + (size_t)1024 * 64 * 128 * 2;
constexpr size_t OFF_GL = OFF_ATT + (size_t)1024 * 64 * 64 * 2;
constexpr size_t OFF_O = OFF_GL + 4096;
constexpr size_t OFF_BD = OFF_O + (size_t)T * 512 * 4;
constexpr size_t OFF_KB = OFF_BD + (size_t)T * 8 * 4;
constexpr size_t OFF_VT = OFF_KB + (size_t)1024 * 1024 * 2;
constexpr size_t OFF_MEMN = OFF_VT + (size_t)1024 * 1024 * 2;
constexpr size_t OFF_BAR = OFF_MEMN + (size_t)1024 * 1024 * 2;
constexpr size_t WS_END = OFF_BAR + 16384;
static_assert(WS_END <= (size_t)4 * 4 * 1024 * INW * 4, "workspace too large");
constexpr size_t OFF_Q = OFF_Z;
constexpr size_t OFF_AO = OFF_Z + (size_t)T * 1024 * 2;
constexpr size_t OFF_HID = OFF_Z;

struct Params {
  const float *x, *mem, *norm_mix, *w_in, *conv_a_w, *conv_a_b, *ln_a_g, *ln_a_b, *dn_conv_w, *dn_a_log, *dn_dt_bias, *dn_norm_g,
      *gm_ln_g, *gm_ln_b, *gm_ws, *gm_bs, *pool_w, *pool_scale, *w_branch, *w_out, *norm_xa, *norm_mem, *xa_wq, *xa_wkv, *xa_wo,
      *norm_mlp, *mlp_w1, *mlp_w2, *norm_f;
  float* out;
  unsigned char* ws;
};

typedef const __attribute__((address_space(4))) Params* PP;
DEVI PP opq(PP p) { asm volatile("" : "+s"(p)); return p; }
DEVI int lane_id() { return (int)__builtin_amdgcn_mbcnt_hi(~0u, __builtin_amdgcn_mbcnt_lo(~0u, 0u)); }
DEVI int otid(int wv) { int t = (wv << 6) | lane_id(); asm volatile("" : "+v"(t)); return t; }
DEVI float bf2f(u16 b) { return __uint_as_float(((unsigned)b) << 16); }
DEVI float bflo(unsigned u) { return __uint_as_float(u << 16); }
DEVI float bfhi(unsigned u) { return __uint_as_float(u & 0xffff0000u); }
DEVI unsigned pk2(float lo, float hi) { return pg8::cvt_pk_bf16(lo, hi); }
DEVI u16 f2bf(float f) { return (u16)(pk2(f, f) & 0xffffu); }
DEVI void unpack8(uint4 r, float* v) { v[0] = bflo(r.x); v[1] = bfhi(r.x); v[2] = bflo(r.y); v[3] = bfhi(r.y); v[4] = bflo(r.z); v[5] = bfhi(r.z); v[6] = bflo(r.w); v[7] = bfhi(r.w); }
DEVI uint4 pack8(const float* v) { uint4 o; o.x = pk2(v[0], v[1]); o.y = pk2(v[2], v[3]); o.z = pk2(v[4], v[5]); o.w = pk2(v[6], v[7]); return o; }
DEVI bf16x8 as_bf8(uint4 u) { union { uint4 a; bf16x8 b; } c; c.a = u; return c.b; }
DEVI float sigmoidf_(float x) { return 1.f / (1.f + __expf(-x)); }
DEVI float siluf_(float x) { return x / (1.f + __expf(-x)); }
DEVI float geluf_(float v) {
  const float t = __builtin_amdgcn_rcpf(fabsf(v) * 0.2316418882f + 1.0f);
  float q = t * 0.5307027145f + (-0.7265760135f); q = q * t + 0.7107068705f; q = q * t + (-0.142248368f); q = q * t + 0.127414796f; q = q * t;
  const float e = __builtin_amdgcn_exp2f((v * v) * (-0.72134752044f));
  const float m = v * (q * e);
  return v < 0.f ? m : v - m;
}
DEVI float wave_sum(float v) {
#pragma unroll
  for (int o = 1; o < 64; o <<= 1) v += __shfl_xor(v, o);
  return v;
}
DEVI void lds_wait() { asm volatile("s_waitcnt lgkmcnt(0)" ::: "memory"); }
DEVI void lds_barrier() { asm volatile("s_waitcnt lgkmcnt(0)" ::: "memory"); __builtin_amdgcn_s_barrier(); asm volatile("" ::: "memory"); }

template <int ACT> struct EpiStore {
  static constexpr bool PERM = true, AFTER_DRAIN = false;
  u16* O; int ldc;
  DEVI void init(f32x4 (&acc)[2][2][4][2], const pg8::Unit&, int, int, int, int) const {
#pragma unroll
    for (int a = 0; a < 2; ++a)
#pragma unroll
      for (int b = 0; b < 2; ++b)
#pragma unroll
        for (int m = 0; m < 4; ++m)
#pragma unroll
          for (int n = 0; n < 2; ++n) acc[a][b][m][n] = (f32x4){0.f, 0.f, 0.f, 0.f};
  }
  DEVI void operator()(const f32x4 (&acc)[2][2][4][2], const pg8::Unit& u, int wr, int wc, int fr, int fq) const {
    const int row0 = u.pm * 256 + wr * 64 + fr, col0 = u.pn * 256 + wc * 32 + 8 * fq;
#pragma unroll
    for (int ai = 0; ai < 2; ++ai)
#pragma unroll
      for (int m = 0; m < 4; ++m) {
        u16* rowp = O + (size_t)(row0 + ai * 128 + m * 16) * ldc + col0;
#pragma unroll
        for (int bj = 0; bj < 2; ++bj) {
          f32x4 v0 = acc[ai][bj][m][0], v1 = acc[ai][bj][m][1];
          if (ACT == 1) {
#pragma unroll
            for (int e = 0; e < 4; ++e) { float a = fmaxf(v0[e], 0.f), b = fmaxf(v1[e], 0.f); v0[e] = a * a; v1[e] = b * b; }
          }
          uint4 o; o.x = pk2(v0[0], v0[1]); o.y = pk2(v0[2], v0[3]); o.z = pk2(v1[0], v1[1]); o.w = pk2(v1[2], v1[3]);
          *(uint4*)(rowp + bj * 128) = o;
        }
      }
  }
};
struct EpiResid {
  static constexpr bool PERM = false, AFTER_DRAIN = false;
  float* X; int ldc;
  DEVI void init(f32x4 (&acc)[2][2][4][2], const pg8::Unit& u, int wr, int wc, int fr, int fq) const {
    const int row0 = u.pm * 256 + wr * 64 + fr, col0 = u.pn * 256 + wc * 32 + 4 * fq;
#pragma unroll
    for (int ai = 0; ai < 2; ++ai)
#pragma unroll
      for (int m = 0; m < 4; ++m) {
        const float* rowp = X + (size_t)(row0 + ai * 128 + m * 16) * ldc + col0;
#pragma unroll
        for (int bj = 0; bj < 2; ++bj)
#pragma unroll
          for (int n = 0; n < 2; ++n) acc[ai][bj][m][n] = *(const f32x4*)(rowp + bj * 128 + n * 16);
      }
  }
  DEVI void operator()(const f32x4 (&acc)[2][2][4][2], const pg8::Unit& u, int wr, int wc, int fr, int fq) const {
    const int row0 = u.pm * 256 + wr * 64 + fr, col0 = u.pn * 256 + wc * 32 + 4 * fq;
#pragma unroll
    for (int ai = 0; ai < 2; ++ai)
#pragma unroll
      for (int m = 0; m < 4; ++m) {
        float* rowp = X + (size_t)(row0 + ai * 128 + m * 16) * ldc + col0;
#pragma unroll
        for (int bj = 0; bj < 2; ++bj)
#pragma unroll
          for (int n = 0; n < 2; ++n) *(f32x4*)(rowp + bj * 128 + n * 16) = acc[ai][bj][m][n];
      }
  }
};
template <int FIRST> struct EpiMerge {
  static constexpr bool PERM = true, AFTER_DRAIN = false;
  u16* Mg; const u16* Zg;
  DEVI void init(f32x4 (&acc)[2][2][4][2], const pg8::Unit&, int, int, int, int) const {
#pragma unroll
    for (int a = 0; a < 2; ++a)
#pragma unroll
      for (int b = 0; b < 2; ++b)
#pragma unroll
        for (int m = 0; m < 4; ++m)
#pragma unroll
          for (int n = 0; n < 2; ++n) acc[a][b][m][n] = (f32x4){0.f, 0.f, 0.f, 0.f};
  }
  DEVI void operator()(const f32x4 (&acc)[2][2][4][2], const pg8::Unit& u, int wr, int wc, int fr, int fq) const {
    const int row0 = u.pm * 256 + wr * 64 + fr, col0 = u.pn * 256 + wc * 32 + 8 * fq;
    uint4 gr[2][2], orr[2][2];
#pragma unroll
    for (int m2 = 0; m2 < 2; ++m2) { const size_t row = (size_t)(row0 + m2 * 16);
      gr[0][m2] = *(const uint4*)(Zg + row * ZW + col0); if (!FIRST) orr[0][m2] = *(const uint4*)(Mg + row * 1024 + col0); }
#pragma unroll
    for (int bt = 0; bt < 8; ++bt) {
      const int ai = bt >> 2, bj = (bt >> 1) & 1, mh = bt & 1, sl = bt & 1;
      if (bt < 7) { const int nai = (bt + 1) >> 2, nbj = ((bt + 1) >> 1) & 1, nmh = (bt + 1) & 1, ns = (bt + 1) & 1;
#pragma unroll
        for (int m2 = 0; m2 < 2; ++m2) { const size_t row = (size_t)(row0 + nai * 128 + (nmh * 2 + m2) * 16);
          gr[ns][m2] = *(const uint4*)(Zg + row * ZW + col0 + nbj * 128); if (!FIRST) orr[ns][m2] = *(const uint4*)(Mg + row * 1024 + col0 + nbj * 128); } }
#pragma unroll
      for (int m2 = 0; m2 < 2; ++m2) {
        const int m = mh * 2 + m2;
        const size_t row = (size_t)(row0 + ai * 128 + m * 16);
        float g[8], o[8];
        unpack8(gr[sl][m2], g);
        if (FIRST) {
#pragma unroll
          for (int e = 0; e < 8; ++e) o[e] = 0.f;
        } else unpack8(orr[sl][m2], o);
        const f32x4 v0 = acc[ai][bj][m][0], v1 = acc[ai][bj][m][1];
#pragma unroll
        for (int e = 0; e < 4; ++e) { o[e] += sigmoidf_(g[e]) * v0[e]; o[4 + e] += sigmoidf_(g[4 + e]) * v1[e]; }
        *(uint4*)(Mg + row * 1024 + col0 + bj * 128) = pack8(o);
      }
    }
  }
};
struct EpiKV {
  static constexpr bool PERM = false, AFTER_DRAIN = false;
  u16* Kb; u16* Vt;
  DEVI void init(f32x4 (&acc)[2][2][4][2], const pg8::Unit&, int, int, int, int) const {
#pragma unroll
    for (int a = 0; a < 2; ++a)
#pragma unroll
      for (int b = 0; b < 2; ++b)
#pragma unroll
        for (int m = 0; m < 4; ++m)
#pragma unroll
          for (int n = 0; n < 2; ++n) acc[a][b][m][n] = (f32x4){0.f, 0.f, 0.f, 0.f};
  }
  DEVI void operator()(const f32x4 (&acc)[2][2][4][2], const pg8::Unit& u, int wr, int wc, int fr, int fq) const {
    const int row0 = u.pm * 256 + wr * 64 + fr, col0 = u.pn * 256 + wc * 32 + 4 * fq;
#pragma unroll
    for (int ai = 0; ai < 2; ++ai)
#pragma unroll
      for (int m = 0; m < 4; ++m) {
        const int row = row0 + ai * 128 + m * 16;
#pragma unroll
        for (int bj = 0; bj < 2; ++bj)
#pragma unroll
          for (int n = 0; n < 2; ++n) {
            const int col = col0 + bj * 128 + n * 16; const f32x4 v = acc[ai][bj][m][n];
            if (u.pn < 4) { uint2 o; o.x = pk2(v[0], v[1]); o.y = pk2(v[2], v[3]); *(uint2*)(Kb + (size_t)row * 1024 + col) = o; }
            else { const int c2 = col - 1024, hh = c2 >> 8, d = c2 & 255, bb = row >> 8, mm = row & 255;
              const int pos = (mm & ~31) | (((mm >> 2) & 3) << 3) | (((mm >> 4) & 1) << 2) | (mm & 3);
              u16* vp = Vt + ((size_t)((bb * 4 + hh) * 256 + d)) * 256 + pos;
#pragma unroll
              for (int e = 0; e < 4; ++e) vp[(size_t)e * 256] = f2bf(v[e]); }
          }
      }
  }
};

template <class Epi> DEVI void run_gemm(int wv, unsigned char* shm, const u16* A, const u16* Bt, int M, int N, int K, const Epi& E) {
  pg8::StaticOrder S; S.init(M, N, (int)gridDim.x, (int)blockIdx.x);
  pg8::Gemm g; g.A = A; g.Bt = Bt; g.M = M; g.N = N; g.K = K;
  pg8::gemm_phase<Epi, pg8::StaticOrder, false>((PG8_LAS unsigned char*)shm, g, S, E, nullptr, wv);
}

template <class Epi> DEVI void run_gemm_sub(int wv, unsigned char* shm, const u16* A, const u16* Bt, int M, int N, int K, const Epi& E, int Gs, int c) {
  pg8::StaticOrder S; S.init(M, N, Gs, c);
  pg8::Gemm g; g.A = A; g.Bt = Bt; g.M = M; g.N = N; g.K = K;
  pg8::gemm_phase<Epi, pg8::StaticOrder, false>((PG8_LAS unsigned char*)shm, g, S, E, nullptr, wv);
}

DEVI void transpose_item(const float* W, int srcN, int n0s, int K, u16* WT, int n0d, int k0, float* scr, int lane) {
  float v[64];
#pragma unroll
  for (int i = 0; i < 64; ++i) v[i] = W[(size_t)(k0 + i) * srcN + n0s + lane];
#pragma unroll
  for (int i = 0; i < 64; ++i) scr[i * 65 + lane] = v[i];
  lds_wait();
  const int c = lane & 7;
#pragma unroll
  for (int j = 0; j < 8; ++j) { const int n = (lane >> 3) + 8 * j; const float* sp = scr + (8 * c) * 65 + n;
    uint4 o; o.x = pk2(sp[0 * 65], sp[1 * 65]); o.y = pk2(sp[2 * 65], sp[3 * 65]); o.z = pk2(sp[4 * 65], sp[5 * 65]); o.w = pk2(sp[6 * 65], sp[7 * 65]);
    *(uint4*)(WT + (size_t)(n0d + n) * K + k0 + 8 * c) = o; }
  lds_wait();
}

template <bool COPY, bool BDC> DEVI void rms_row(const float* xrow, const float* gain, u16* orow, float* copyrow, const float* wbd, float* bdrow, int lane) {
  const f32x4* xr = (const f32x4*)xrow + lane;
  f32x4 v[4]; float s = 0.f;
#pragma unroll
  for (int j = 0; j < 4; ++j) { v[j] = xr[64 * j]; s += (v[j][0] * v[j][0] + v[j][1] * v[j][1]) + (v[j][2] * v[j][2] + v[j][3] * v[j][3]); }
  if (COPY) {
#pragma unroll
    for (int j = 0; j < 4; ++j) ((f32x4*)copyrow)[lane + 64 * j] = v[j];
  }
  const float rstd = rsqrtf(wave_sum(s) * (1.f / 1024.f) + 1e-6f);
#pragma unroll
  for (int j = 0; j < 4; ++j) { const f32x4 g = ((const f32x4*)gain)[lane + 64 * j]; v[j] = v[j] * rstd * g; }
  uint2* o8 = (uint2*)orow + lane;
#pragma unroll
  for (int j = 0; j < 4; ++j) { uint2 o; o.x = pk2(v[j][0], v[j][1]); o.y = pk2(v[j][2], v[j][3]); o8[64 * j] = o; }
  if (BDC) {
    float a[8];
#pragma unroll
    for (int e = 0; e < 8; ++e) a[e] = 0.f;
#pragma unroll
    for (int j = 0; j < 4; ++j)
#pragma unroll
      for (int q = 0; q < 4; ++q) { const int k = 4 * (lane + 64 * j) + q; const f32x4 w0 = *(const f32x4*)(wbd + (size_t)k * INW), w1 = *(const f32x4*)(wbd + (size_t)k * INW + 4);
        const float hv = v[j][q];
        a[0] += hv * w0[0]; a[1] += hv * w0[1]; a[2] += hv * w0[2]; a[3] += hv * w0[3]; a[4] += hv * w1[0]; a[5] += hv * w1[1]; a[6] += hv * w1[2]; a[7] += hv * w1[3]; }
#pragma unroll
    for (int e = 0; e < 8; ++e) a[e] = wave_sum(a[e]);
    if (lane == 0) { f32x4 o0 = {a[0], a[1], a[2], a[3]}, o1 = {a[4], a[5], a[6], a[7]}; *(f32x4*)bdrow = o0; *(f32x4*)(bdrow + 4) = o1; }
  }
}


template <bool COPY> DEVI void rms_rows4(const float* xbase, size_t rstride, const float* gain, u16* obase, float* cbase, int lane) {
  f32x4 v[4][4]; float s[4];
#pragma unroll
  for (int r = 0; r < 4; ++r) { const f32x4* xr = (const f32x4*)(xbase + r * rstride) + lane;
#pragma unroll
    for (int j = 0; j < 4; ++j) v[r][j] = xr[64 * j]; }
#pragma unroll
  for (int r = 0; r < 4; ++r) { float a = 0.f;
#pragma unroll
    for (int j = 0; j < 4; ++j) a += (v[r][j][0] * v[r][j][0] + v[r][j][1] * v[r][j][1]) + (v[r][j][2] * v[r][j][2] + v[r][j][3] * v[r][j][3]);
    s[r] = a; }
  if (COPY) {
#pragma unroll
    for (int r = 0; r < 4; ++r)
#pragma unroll
      for (int j = 0; j < 4; ++j) ((f32x4*)(cbase + r * rstride))[lane + 64 * j] = v[r][j];
  }
#pragma unroll
  for (int o = 1; o < 64; o <<= 1) {
#pragma unroll
    for (int r = 0; r < 4; ++r) s[r] += __shfl_xor(s[r], o);
  }
  f32x4 g[4];
#pragma unroll
  for (int j = 0; j < 4; ++j) g[j] = ((const f32x4*)gain)[lane + 64 * j];
#pragma unroll
  for (int r = 0; r < 4; ++r) { const float rstd = rsqrtf(s[r] * (1.f / 1024.f) + 1e-6f); uint2* o8 = (uint2*)(obase + r * rstride) + lane;
#pragma unroll
    for (int j = 0; j < 4; ++j) { const f32x4 y = v[r][j] * rstd * g[j]; uint2 o; o.x = pk2(y[0], y[1]); o.y = pk2(y[2], y[3]); o8[64 * j] = o; } }
}

DEVI void phase_prep(int wv, PP p, int l, unsigned char* shm) {
  const int tid = otid(wv), wid = tid >> 6, lane = tid & 63;
  const int gw = blockIdx.x * 8 + wid, nw = gridDim.x * 8;
  float* scr = (float*)(shm + wid * 16640);
  unsigned char* ws = p->ws;
  const float* w_in = p->w_in + (size_t)l * 1024 * INW;
  for (int it = gw; it < 6048; it += nw) {
    int r = it;
    if (r < 2192) { const int kb = r / 137, n0 = (r % 137) * 64; transpose_item(w_in, INW, n0 >= 8704 ? 3072 : n0 + (n0 >= 3072 ? 8 : 0), 1024, (u16*)(ws + OFF_WT_IN), n0, kb * 64, scr, lane); continue; }
    r -= 2192;
    if (r < 512) { const int i = r >> 7; r &= 127; transpose_item(p->w_branch + ((size_t)l * 4 + i) * 512 * 1024, 1024, (r & 15) * 64, 512, (u16*)(ws + OFF_WT_BR) + (size_t)i * 1024 * 512, (r & 15) * 64, (r >> 4) * 64, scr, lane); continue; }
    r -= 512;
    if (r < 256) { transpose_item(p->w_out + (size_t)l * 1024 * 1024, 1024, (r & 15) * 64, 1024, (u16*)(ws + OFF_WT_OUT), (r & 15) * 64, (r >> 4) * 64, scr, lane); continue; }
    r -= 256;
    if (r < 256) { transpose_item(p->xa_wq + (size_t)l * 1024 * 1024, 1024, (r & 15) * 64, 1024, (u16*)(ws + OFF_WT_Q), (r & 15) * 64, (r >> 4) * 64, scr, lane); continue; }
    r -= 256;
    if (r < 512) { transpose_item(p->xa_wkv + (size_t)l * 1024 * 2048, 2048, (r & 31) * 64, 1024, (u16*)(ws + OFF_WT_KV), (r & 31) * 64, (r >> 5) * 64, scr, lane); continue; }
    r -= 512;
    if (r < 256) { transpose_item(p->xa_wo + (size_t)l * 1024 * 1024, 1024, (r & 15) * 64, 1024, (u16*)(ws + OFF_WT_O), (r & 15) * 64, (r >> 4) * 64, scr, lane); continue; }
    r -= 256;
    if (r < 1024) { transpose_item(p->mlp_w1 + (size_t)l * 1024 * 4096, 4096, (r & 63) * 64, 1024, (u16*)(ws + OFF_WT_1), (r & 63) * 64, (r >> 6) * 64, scr, lane); continue; }
    r -= 1024;
    if (r < 1024) { transpose_item(p->mlp_w2 + (size_t)l * 4096 * 1024, 1024, (r & 15) * 64, 4096, (u16*)(ws + OFF_WT_2), (r & 15) * 64, (r >> 4) * 64, scr, lane); continue; }
    r -= 1024;
    { const int g = r >> 2; r &= 3; transpose_item(p->pool_w + ((size_t)l * 4 + g) * 16384, 128, (r & 1) * 64, 128, (u16*)(ws + OFF_POOLT) + (size_t)g * 16384, (r & 1) * 64, (r >> 1) * 64, scr, lane); }
  }
  for (int row = gw; row < T; row += 4 * nw) {
    if (l == 0) rms_rows4<true>(p->x + (size_t)row * 1024, (size_t)nw * 1024, p->norm_mix + l * 1024, (u16*)(ws + OFF_HM) + (size_t)row * 1024, p->out + (size_t)row * 1024, lane);
    else rms_rows4<false>(p->out + (size_t)row * 1024, (size_t)nw * 1024, p->norm_mix + l * 1024, (u16*)(ws + OFF_HM) + (size_t)row * 1024, nullptr, lane);
  }
  for (int row = gw; row < 1024; row += nw)
    rms_row<false, false>(p->mem + (size_t)row * 1024, p->norm_mem + l * 1024, (u16*)(ws + OFF_MEMN) + (size_t)row * 1024, nullptr, nullptr, nullptr, lane);
}

DEVI void phase_norm(int wv, PP p, const float* gain, unsigned char* shm) {
  const int tid = otid(wv), wid = tid >> 6, lane = tid & 63;
  const int gw = blockIdx.x * 8 + wid, nw = gridDim.x * 8;
  for (int row = gw; row < T; row += 4 * nw)
    rms_rows4<false>(p->out + (size_t)row * 1024, (size_t)nw * 1024, gain, (u16*)(p->ws + OFF_HM) + (size_t)row * 1024, nullptr, lane);
}

DEVI void phase_final(int wv, PP p) {
  const int tid = otid(wv), wid = tid >> 6, lane = tid & 63;
  const int gw = blockIdx.x * 8 + wid, nw = gridDim.x * 8;
  f32x4 g[4];
#pragma unroll
  for (int j = 0; j < 4; ++j) g[j] = ((const f32x4*)p->norm_f)[lane + 64 * j];
  for (int row0 = gw; row0 < T; row0 += 4 * nw) {
    f32x4 v[4][4]; float s[4];
#pragma unroll
    for (int r = 0; r < 4; ++r) { const f32x4* xr = (const f32x4*)(p->out + ((size_t)row0 + (size_t)r * nw) * 1024) + lane;
#pragma unroll
      for (int j = 0; j < 4; ++j) v[r][j] = xr[64 * j]; }
#pragma unroll
    for (int r = 0; r < 4; ++r) { float acc = 0.f;
#pragma unroll
      for (int j = 0; j < 4; ++j) acc += (v[r][j][0] * v[r][j][0] + v[r][j][1] * v[r][j][1]) + (v[r][j][2] * v[r][j][2] + v[r][j][3] * v[r][j][3]);
      s[r] = acc; }
#pragma unroll
    for (int o = 1; o < 64; o <<= 1) {
#pragma unroll
      for (int r = 0; r < 4; ++r) s[r] += __shfl_xor(s[r], o);
    }
#pragma unroll
    for (int r = 0; r < 4; ++r) { const float rstd = rsqrtf(s[r] * (1.f / 1024.f) + 1e-6f); f32x4* xr = (f32x4*)(p->out + ((size_t)row0 + (size_t)r * nw) * 1024) + lane;
#pragma unroll
      for (int j = 0; j < 4; ++j) xr[64 * j] = v[r][j] * rstd * g[j]; }
  }
}

DEVI void phase_dn_pre(int wv, PP p, int l, unsigned char* shm) {
  unsigned char* ws = p->ws;
  const u16* Z = (const u16*)(ws + OFF_Z);
  const float* cwl = p->dn_conv_w + (size_t)l * 4 * 1536;
  const int nit = (gridDim.x == 256) ? 2 : (512 + (int)gridDim.x - 1 - (int)blockIdx.x) / (int)gridDim.x;
  for (int itp = 0; itp < nit; ++itp) {
    const int pu = (gridDim.x == 256) ? ((((int)(blockIdx.x & 7) >> 1) * 64 + ((int)(blockIdx.x >> 3) + 32 * (1 - itp))) * 2 + (int)(blockIdx.x & 1)) : ((int)blockIdx.x + itp * (int)gridDim.x);
    const int tid = otid(wv), half = tid >> 8, ht = tid & 255, hw = (tid >> 6) & 3, lane = tid & 63, fr = lane & 15, fq = lane >> 4;
    unsigned char* hb = shm + half * 70656;
    u16* qn = (u16*)hb; u16* kn = qn + 64 * 136; u16* vb = kn + 64 * 136;
    float* Am = (float*)(vb + 64 * 136); float* gam = Am + 64 * 68; float* bet = gam + 64; float* eg = bet + 64; float* ek = eg + 64;
    const int cidx = pu >> 1, h = (pu & 1) * 2 + half, b = cidx >> 6, n = cidx & 63;
    const int t0 = b * 4096 + n * 64, ch = cidx * 4 + h;
    {
      const int sub = ht & 15, i0 = (ht >> 4) * 4, sq0 = n * 64 + i0;
      const u16* zrow = Z + (size_t)(t0 + i0) * ZW;
#pragma unroll
      for (int ten = 0; ten < 3; ++ten) {
        const int zc = 1024 + ten * 512 + h * 128 + sub * 8;
        const float* cw = cwl + ten * 512 + h * 128 + sub * 8;
        uint4 raw[7]; f32x4 w0[4], w1[4];
#pragma unroll
        for (int r = 0; r < 7; ++r) { const int ro = (sq0 + r - 3 >= 0) ? (r - 3) : 0; raw[r] = *(const uint4*)(zrow + (ptrdiff_t)ro * ZW + zc); }
#pragma unroll
        for (int kk = 0; kk < 4; ++kk) { w0[kk] = *(const f32x4*)(cw + kk * 1536); w1[kk] = *(const f32x4*)(cw + kk * 1536 + 4); }
        float xr[7][8];
#pragma unroll
        for (int r = 0; r < 7; ++r) { unpack8(raw[r], xr[r]); const float mk = (sq0 + r - 3 >= 0) ? 1.f : 0.f;
#pragma unroll
          for (int e = 0; e < 8; ++e) xr[r][e] *= mk; }
#pragma unroll
        for (int tk = 0; tk < 4; ++tk) {
          float val[8]; float ss = 0.f;
#pragma unroll
          for (int e = 0; e < 8; ++e) {
            float a = 0.f;
#pragma unroll
            for (int kk = 0; kk < 4; ++kk) a += (e < 4 ? w0[kk][e & 3] : w1[kk][e & 3]) * xr[tk + kk][e];
            const float y = siluf_(a); val[e] = y; ss += y * y;
          }
          if (ten < 2) {
            ss += __shfl_xor(ss, 1); ss += __shfl_xor(ss, 2); ss += __shfl_xor(ss, 4); ss += __shfl_xor(ss, 8);
            const float sc = rsqrtf(ss + 1e-6f) * (ten == 0 ? 0.08838834764831845f : 1.f);
#pragma unroll
            for (int e = 0; e < 8; ++e) val[e] *= sc;
          }
          u16* dst = (ten == 0 ? qn : (ten == 1 ? kn : vb)) + (i0 + tk) * 136 + sub * 8;
          *(uint4*)dst = pack8(val);
        }
      }
    }
    if (hw == 0) {
      const u16* bd = Z + (size_t)(t0 + lane) * ZW + 8704;
      const float be = sigmoidf_(bf2f(bd[h]));
      const float xg = bf2f(bd[4 + h]) + p->dn_dt_bias[l * 4 + h];
      const float sp = xg > 20.f ? xg : log1pf(expf(xg));
      float g = -expf(p->dn_a_log[l * 4 + h]) * sp;
#pragma unroll
      for (int o = 1; o < 64; o <<= 1) { const float y = __shfl_up(g, o); if (lane >= o) g += y; }
      gam[lane] = g; bet[lane] = be; eg[lane] = expf(g); ek[lane] = expf(__shfl(g, 63) - g);
    }
    __syncthreads();
    {
      bf16x8 ak[4], aq[4];
#pragma unroll
      for (int ks = 0; ks < 4; ++ks) { ak[ks] = *(const bf16x8*)(kn + (hw * 16 + fr) * 136 + ks * 32 + fq * 8); aq[ks] = *(const bf16x8*)(qn + (hw * 16 + fr) * 136 + ks * 32 + fq * 8); }
      u16* att = (u16*)(ws + OFF_ATT) + (size_t)ch * 4096;
#pragma unroll
      for (int nt = 0; nt < 4; ++nt) {
        f32x4 ckk = {0.f, 0.f, 0.f, 0.f}, cqk = {0.f, 0.f, 0.f, 0.f};
        if (nt <= hw) {
#pragma unroll
          for (int ks = 0; ks < 4; ++ks) { const bf16x8 bfr = *(const bf16x8*)(kn + (nt * 16 + fr) * 136 + ks * 32 + fq * 8); ckk = MFMA16(ak[ks], bfr, ckk); cqk = MFMA16(aq[ks], bfr, cqk); }
        }
        const int jj = nt * 16 + fr; const float gj = gam[jj];
#pragma unroll
        for (int j = 0; j < 4; ++j) {
          const int i = hw * 16 + fq * 4 + j;
          const float dec = (i >= jj) ? __expf(gam[i] - gj) : 0.f;
          Am[i * 68 + jj] = (i > jj) ? bet[i] * ckk[j] * dec : 0.f;
          att[i * 64 + jj] = f2bf(cqk[j] * dec);
        }
      }
    }
    {
      const int i = ht >> 2, sub = ht & 3; const float egi = eg[i];
      u16* qd = (u16*)(ws + OFF_QD) + ((size_t)ch * 64 + i) * 128 + sub * 32;
#pragma unroll
      for (int c8 = 0; c8 < 4; ++c8) { float v[8]; unpack8(*(const uint4*)(qn + i * 136 + sub * 32 + c8 * 8), v);
#pragma unroll
        for (int e = 0; e < 8; ++e) v[e] *= egi;
        *(uint4*)(qd + c8 * 8) = pack8(v); }
      const int k = ht & 127, ih = ht >> 7;
      u16* kd = (u16*)(ws + OFF_KDT) + ((size_t)ch * 128 + k) * 64 + ih * 32;
#pragma unroll
      for (int c8 = 0; c8 < 4; ++c8) { float v[8];
#pragma unroll
        for (int e = 0; e < 8; ++e) { const int ii = ih * 32 + c8 * 8 + e; v[e] = bf2f(kn[ii * 136 + k]) * ek[ii]; }
        *(uint4*)(kd + c8 * 8) = pack8(v); }
      if (ht == 0) ((float*)(ws + OFF_GL))[ch] = eg[63];
    }
    __syncthreads();
    {
      const int col = ht; const bool isw = col >= 128;
      const u16* src = isw ? kn + (col - 128) : vb + col;
      float x[64]; int zo[64];
#pragma unroll
      for (int i = 0; i < 64; ++i) {
        const int zz = (i >= 2) ? zo[i - 2] : 0;
        float r = bf2f(src[i * 136 + zz]) * bet[i + zz]; if (isw) r *= eg[i + zz];
        const float* arow = Am + i * 68 + zz; float ra = 0.f, rb = 0.f;
#pragma unroll
        for (int j4 = 0; j4 < (i + 3) / 4; ++j4) {
          const f32x4 a = *(const f32x4*)(arow + j4 * 4);
#pragma unroll
          for (int e = 0; e < 4; ++e) if (j4 * 4 + e < i) { if (j4 & 1) rb += a[e] * x[j4 * 4 + e]; else ra += a[e] * x[j4 * 4 + e]; }
        }
        r -= ra + rb;
        x[i] = r;
        asm volatile("v_and_b32 %0, 0, %1" : "=v"(zo[i]) : "v"(__float_as_int(r)));
      }
      u16* dst = (u16*)(ws + (isw ? OFF_W : OFF_U)) + (size_t)ch * 8192 + (col & 127);
#pragma unroll
      for (int i = 0; i < 64; ++i) dst[i * 128] = f2bf(x[i]);
    }
    __syncthreads();
  }
}

DEVI void phase_dn_scan(int wv, PP p, unsigned char* shm) {
  const int tid = otid(wv), wid = tid >> 6, lane = tid & 63, fr = lane & 15, fq = lane >> 4;
  const int bid = blockIdx.x, xcd = bid & 7, idx = bid >> 3, stream = xcd * 2 + (idx >> 3), slice = idx & 7;
  const int b = stream >> 2, h = stream & 3, mt = wid & 3; const bool isV = wid < 4;
  unsigned char* ws = p->ws;
  u16* Sb = (u16*)shm; u16* Vb = Sb + 16 * 136;
  const u16* Abase = (const u16*)(ws + (isV ? OFF_W : OFF_QD));
  const u16* KDT = (const u16*)(ws + OFF_KDT); const u16* ATT = (const u16*)(ws + OFF_ATT); const u16* U = (const u16*)(ws + OFF_U);
  const float* GL = (const float*)(ws + OFF_GL); float* O = (float*)(ws + OFF_O);
  f32x4 sacc = {0.f, 0.f, 0.f, 0.f};
#define SCAN_LOAD(AF, KF, TF, UU, GLV, NIDX) do { const int ch_ = (b * 64 + (NIDX)) * 4 + h; \
    _Pragma("unroll") for (int ks = 0; ks < 4; ++ks) AF[ks] = *(const bf16x8*)(Abase + ((size_t)ch_ * 64 + mt * 16 + fr) * 128 + ks * 32 + fq * 8); \
    _Pragma("unroll") for (int ks = 0; ks < 2; ++ks) KF[ks] = *(const bf16x8*)(KDT + ((size_t)ch_ * 128 + wid * 16 + fr) * 64 + ks * 32 + fq * 8); \
    if (isV) { _Pragma("unroll") for (int j = 0; j < 4; ++j) UU[j] = U[((size_t)ch_ * 64 + mt * 16 + fq * 4 + j) * 128 + slice * 16 + fr]; \
      _Pragma("unroll") for (int ks = 0; ks < 2; ++ks) TF[ks] = (bf16x8){0, 0, 0, 0, 0, 0, 0, 0}; } \
    else { _Pragma("unroll") for (int ks = 0; ks < 2; ++ks) TF[ks] = *(const bf16x8*)(ATT + ((size_t)ch_ * 64 + mt * 16 + fr) * 64 + ks * 32 + fq * 8); \
      _Pragma("unroll") for (int j = 0; j < 4; ++j) UU[j] = 0; } \
    GLV = GL[ch_]; } while (0)
  bf16x8 af[4], kf[2], tf[2]; u16 uu[4]; float gl;
  bf16x8 af1[4], kf1[2], tf1[2]; u16 uu1[4]; float gl1;
  SCAN_LOAD(af, kf, tf, uu, gl, 0);
  SCAN_LOAD(af1, kf1, tf1, uu1, gl1, 1);
#pragma unroll 1
  for (int n = 0; n < 64; ++n) {
    const int nn = n < 62 ? n + 2 : 63;
    bf16x8 naf[4], nkf[2], ntf[2]; u16 nuu[4]; float ngl;
    SCAN_LOAD(naf, nkf, ntf, nuu, ngl, nn);
    { uint2 o; o.x = pk2(sacc[0], sacc[1]); o.y = pk2(sacc[2], sacc[3]); *(uint2*)(Sb + fr * 136 + wid * 16 + fq * 4) = o; }
    lds_barrier();
    f32x4 acc = {0.f, 0.f, 0.f, 0.f};
#pragma unroll
    for (int ks = 0; ks < 4; ++ks) { const bf16x8 sf = *(const bf16x8*)(Sb + fr * 136 + ks * 32 + fq * 8); acc = MFMA16(af[ks], sf, acc); }
    if (isV) { uint2 o; o.x = pk2(bf2f(uu[0]) - acc[0], bf2f(uu[1]) - acc[1]); o.y = pk2(bf2f(uu[2]) - acc[2], bf2f(uu[3]) - acc[3]); *(uint2*)(Vb + fr * 72 + mt * 16 + fq * 4) = o; }
    lds_barrier();
    const bf16x8 vf0 = *(const bf16x8*)(Vb + fr * 72 + fq * 8), vf1 = *(const bf16x8*)(Vb + fr * 72 + 32 + fq * 8);
    if (!isV) {
      acc = MFMA16(tf[0], vf0, acc); acc = MFMA16(tf[1], vf1, acc);
      const int t0 = b * 4096 + n * 64;
#pragma unroll
      for (int j = 0; j < 4; ++j) O[(size_t)(t0 + mt * 16 + fq * 4 + j) * 512 + h * 128 + slice * 16 + fr] = acc[j];
    }
    sacc = sacc * gl;
    sacc = MFMA16(kf[0], vf0, sacc); sacc = MFMA16(kf[1], vf1, sacc);
#pragma unroll
    for (int ks = 0; ks < 4; ++ks) { af[ks] = af1[ks]; af1[ks] = naf[ks]; }
#pragma unroll
    for (int ks = 0; ks < 2; ++ks) { kf[ks] = kf1[ks]; tf[ks] = tf1[ks]; kf1[ks] = nkf[ks]; tf1[ks] = ntf[ks]; }
#pragma unroll
    for (int j = 0; j < 4; ++j) { uu[j] = uu1[j]; uu1[j] = nuu[j]; }
    gl = gl1; gl1 = ngl;
  }
#undef SCAN_LOAD
}

DEVI void unit_conv(int wv, PP p, int l, int tile, unsigned char* shm) {
  const int tid = otid(wv), wid = tid >> 6, lane = tid & 63;
  u16* at = (u16*)shm; float* yt = (float*)(shm + 63488);
  const u16* Z = (const u16*)(p->ws + OFF_Z);
  const int t0 = tile * 32, s0 = t0 & 4095;
  {
    uint4 r1[8], r2[8];
#pragma unroll
    for (int i = 0; i < 8; ++i) { const int it = tid + i * 512, r = it >> 6, c8 = (it & 63) * 8; const int rr = (s0 - 30 + r >= 0 && it < 62 * 64) ? (r - 30) : 0;
      const u16* zr = Z + (ptrdiff_t)(t0 + rr) * ZW; r1[i] = *(const uint4*)(zr + c8); r2[i] = *(const uint4*)(zr + 512 + c8); }
#pragma unroll
    for (int i = 0; i < 8; ++i) { const int it = tid + i * 512, r = it >> 6, c8 = (it & 63) * 8;
      if (it < 62 * 64) { uint4 o = {0u, 0u, 0u, 0u};
        if (s0 - 30 + r >= 0) { float a1[8], a2[8]; unpack8(r1[i], a1); unpack8(r2[i], a2);
#pragma unroll
          for (int e = 0; e < 8; ++e) a1[e] *= sigmoidf_(a2[e]);
          o = pack8(a1); }
        *(uint4*)(at + r * 512 + c8) = o; } }
  }
  __syncthreads();
  {
    const int c = tid; float w[31];
    const float* cw = p->conv_a_w + (size_t)l * 31 * 512 + c;
#pragma unroll
    for (int k = 0; k < 31; ++k) w[k] = cw[k * 512];
    const float bias = p->conv_a_b[l * 512 + c];
    float acc[32];
#pragma unroll
    for (int t = 0; t < 32; ++t) acc[t] = bias;
#pragma unroll
    for (int r = 0; r < 62; ++r) { const float v = bf2f(at[r * 512 + c]);
#pragma unroll
      for (int t = 0; t < 32; ++t) if (r - t >= 0 && r - t <= 30) acc[t] += w[r - t] * v; }
#pragma unroll
    for (int t = 0; t < 32; ++t) yt[t * 512 + c] = acc[t];
  }
  __syncthreads();
  {
    const float* lg = p->ln_a_g + l * 512 + lane * 8; const float* lb = p->ln_a_b + l * 512 + lane * 8;
    u16* out = (u16*)(p->ws + OFF_BR);
#pragma unroll
    for (int tt = 0; tt < 4; ++tt) {
      const int t = wid * 4 + tt;
      const f32x4 v0 = *(const f32x4*)(yt + t * 512 + lane * 8), v1 = *(const f32x4*)(yt + t * 512 + lane * 8 + 4);
      float v[8] = {v0[0], v0[1], v0[2], v0[3], v1[0], v1[1], v1[2], v1[3]};
      float s = 0.f;
#pragma unroll
      for (int e = 0; e < 8; ++e) s += v[e];
      const float mean = wave_sum(s) * (1.f / 512.f); float s2 = 0.f;
#pragma unroll
      for (int e = 0; e < 8; ++e) { v[e] -= mean; s2 += v[e] * v[e]; }
      const float rstd = rsqrtf(wave_sum(s2) * (1.f / 512.f) + 1e-5f);
#pragma unroll
      for (int e = 0; e < 8; ++e) v[e] = siluf_(v[e] * rstd * lg[e] + lb[e]);
      *(uint4*)(out + (size_t)(t0 + t) * 512 + lane * 8) = pack8(v);
    }
  }
  __syncthreads();
}

DEVI void unit_gmlp(int wv, PP p, int l, int u, unsigned char* shm) {
  const int tid = otid(wv), wid = tid >> 6, lane = tid & 63, fr = lane & 15, fq = lane >> 4;
  const int chunk = u >> 2, g = u & 3, T0 = chunk * 128;
  u16* vT = (u16*)shm; u16* uT = vT + 128 * 136;
  const u16* Z = (const u16*)(p->ws + OFF_Z);
  {
    uint4 raw[16], ur[4];
#pragma unroll
    for (int tt = 0; tt < 16; ++tt) raw[tt] = *(const uint4*)(Z + (size_t)(T0 + wid * 16 + tt) * ZW + 3072 + 512 + lane * 8);
#pragma unroll
    for (int i = 0; i < 4; ++i) { const int it = tid + i * 512, r = it >> 4, c8 = (it & 15) * 8; ur[i] = *(const uint4*)(Z + (size_t)(T0 + r) * ZW + 3072 + g * 128 + c8); }
#pragma unroll
    for (int i = 0; i < 4; ++i) { const int it = tid + i * 512, r = it >> 4, c8 = (it & 15) * 8; *(uint4*)(uT + r * 136 + c8) = ur[i]; }
    const int cl = fr * 8; const float* lg = p->gm_ln_g + l * 512 + g * 128 + cl; const float* lb = p->gm_ln_b + l * 512 + g * 128 + cl;
#pragma unroll
    for (int tb = 0; tb < 16; tb += 4) {
      float v[4][8], s1[4], s2[4];
#pragma unroll
      for (int k = 0; k < 4; ++k) { unpack8(raw[tb + k], v[k]); float a = 0.f, b2 = 0.f;
#pragma unroll
        for (int e = 0; e < 8; ++e) { v[k][e] = geluf_(v[k][e]); a += v[k][e]; b2 += v[k][e] * v[k][e]; }
        s1[k] = a; s2[k] = b2; }
#pragma unroll
      for (int o = 1; o < 64; o <<= 1) {
#pragma unroll
        for (int k = 0; k < 4; ++k) { s1[k] += __shfl_xor(s1[k], o); s2[k] += __shfl_xor(s2[k], o); }
      }
      if (fq == g) {
#pragma unroll
        for (int k = 0; k < 4; ++k) {
          const int tl = wid * 16 + tb + k;
          const float mean = s1[k] * (1.f / 512.f), var = fmaxf(s2[k] * (1.f / 512.f) - mean * mean, 0.f), rstd = rsqrtf(var + 1e-5f);
#pragma unroll
          for (int e = 0; e < 8; ++e) vT[(cl + e) * 136 + tl] = f2bf((v[k][e] - mean) * rstd * lg[e] + lb[e]);
        }
      }
      __builtin_amdgcn_sched_barrier(0);
    }
  }
  __syncthreads();
  f32x4 acc[8];
#pragma unroll
  for (int nt = 0; nt < 8; ++nt) acc[nt] = (f32x4){0.f, 0.f, 0.f, 0.f};
  const float* Wg = p->gm_ws + ((size_t)l * 4 + g) * 16384;
#pragma unroll
  for (int ks = 0; ks < 4; ++ks) {
    if (ks * 32 <= wid * 16 + 15) {
      const int t = wid * 16 + fr, sb = ks * 32 + fq * 8;
      const f32x4 w0 = *(const f32x4*)(Wg + t * 128 + sb), w1 = *(const f32x4*)(Wg + t * 128 + sb + 4);
      float wv[8] = {w0[0], w0[1], w0[2], w0[3], w1[0], w1[1], w1[2], w1[3]};
#pragma unroll
      for (int e = 0; e < 8; ++e) if (sb + e > t) wv[e] = 0.f;
      const bf16x8 afr = as_bf8(pack8(wv));
#pragma unroll
      for (int nt = 0; nt < 8; ++nt) { const bf16x8 bfr = *(const bf16x8*)(vT + (nt * 16 + fr) * 136 + ks * 32 + fq * 8); acc[nt] = MFMA16(afr, bfr, acc[nt]); }
    }
  }
  u16* out = (u16*)(p->ws + OFF_BR) + (size_t)2 * T * 512;
#pragma unroll
  for (int j = 0; j < 4; ++j) {
    const int tl = wid * 16 + fq * 4 + j; const float bs = p->gm_bs[(l * 4 + g) * 128 + tl];
#pragma unroll
    for (int nt = 0; nt < 8; ++nt) {
      const int c = nt * 16 + fr;
      const float uu = geluf_(bf2f(uT[tl * 136 + c]));
      out[(size_t)(T0 + tl) * 512 + g * 128 + c] = f2bf(uu * (acc[nt][j] + bs));
    }
  }
  __syncthreads();
}

DEVI void unit_pool(int wv, PP p, int l, int u, unsigned char* shm) {
  const int tid = otid(wv), wid = tid >> 6, lane = tid & 63, fr = lane & 15, fq = lane >> 4;
  const int tile = u >> 2, gi = u & 3, win = 2 << gi, T0 = tile * 128, s0 = T0 & 4095;
  float* xs = (float*)shm; u16* pA = (u16*)(shm + 143 * 128 * 4);
  const u16* Z = (const u16*)(p->ws + OFF_Z);
  {
    uint4 raw[5];
#pragma unroll
    for (int i = 0; i < 5; ++i) { const int it = tid + i * 512, r = it >> 4, c8 = (it & 15) * 8; const int rr = (s0 - 15 + r >= 0 && it < 143 * 16) ? (r - 15) : 0;
      raw[i] = *(const uint4*)(Z + (ptrdiff_t)(T0 + rr) * ZW + 4096 + gi * 128 + c8); }
#pragma unroll
    for (int i = 0; i < 5; ++i) { const int it = tid + i * 512, r = it >> 4, c8 = (it & 15) * 8;
      if (it < 143 * 16) { float v[8]; unpack8(raw[i], v); const float mk = (s0 - 15 + r >= 0) ? 1.f : 0.f;
        *(f32x4*)(xs + r * 128 + c8) = (f32x4){v[0] * mk, v[1] * mk, v[2] * mk, v[3] * mk}; *(f32x4*)(xs + r * 128 + c8 + 4) = (f32x4){v[4] * mk, v[5] * mk, v[6] * mk, v[7] * mk}; } }
  }
  __syncthreads();
  {
    const int c = tid & 127, tstart = (tid >> 7) * 32;
    float S = 0.f;
    for (int k = 0; k < win; ++k) S += xs[(tstart + 15 - k) * 128 + c];
    for (int tt = 0; tt < 32; ++tt) {
      const int tl = tstart + tt;
      if (tt > 0) S += xs[(tl + 15) * 128 + c] - xs[(tl + 15 - win) * 128 + c];
      const int s = s0 + tl; const float cnt = (float)(s + 1 < win ? s + 1 : win);
      pA[tl * 136 + c] = f2bf(S / cnt - xs[(tl + 15) * 128 + c]);
    }
  }
  __syncthreads();
  f32x4 acc[8];
#pragma unroll
  for (int nt = 0; nt < 8; ++nt) acc[nt] = (f32x4){0.f, 0.f, 0.f, 0.f};
  const u16* Bt = (const u16*)(p->ws + OFF_POOLT) + (size_t)gi * 16384;
#pragma unroll
  for (int ks = 0; ks < 4; ++ks) {
    const bf16x8 afr = *(const bf16x8*)(pA + (wid * 16 + fr) * 136 + ks * 32 + fq * 8);
#pragma unroll
    for (int nt = 0; nt < 8; ++nt) { const bf16x8 bfr = *(const bf16x8*)(Bt + (nt * 16 + fr) * 128 + ks * 32 + fq * 8); acc[nt] = MFMA16(afr, bfr, acc[nt]); }
  }
  u16* out = (u16*)(p->ws + OFF_BR) + (size_t)3 * T * 512;
#pragma unroll
  for (int nt = 0; nt < 8; ++nt) {
    const int d = nt * 16 + fr; const float sc = p->pool_scale[l * 512 + gi * 128 + d];
#pragma unroll
    for (int j = 0; j < 4; ++j) { const int tl = wid * 16 + fq * 4 + j; out[(size_t)(T0 + tl) * 512 + gi * 128 + d] = f2bf(acc[nt][j] * sc); }
  }
  __syncthreads();
}

DEVI void phase_dn_post(int wv, PP p, int l) {
  const int tid = otid(wv), wid = tid >> 6, lane = tid & 63;
  const int gw = blockIdx.x * 8 + wid, nw = gridDim.x * 8;
  const float* O = (const float*)(p->ws + OFF_O); const u16* Z = (const u16*)(p->ws + OFF_Z);
  u16* out = (u16*)(p->ws + OFF_BR) + (size_t)1 * T * 512;
  const float* ng = p->dn_norm_g + l * 128 + (lane & 15) * 8;
  float gn[8];
#pragma unroll
  for (int e = 0; e < 8; ++e) gn[e] = ng[e];
  for (int row0 = gw; row0 < T; row0 += 4 * nw) {
    f32x4 a[4], b2[4]; uint4 gr[4]; float ss[4];
#pragma unroll
    for (int r = 0; r < 4; ++r) { const size_t row = (size_t)row0 + (size_t)r * nw;
      a[r] = *(const f32x4*)(O + row * 512 + lane * 8); b2[r] = *(const f32x4*)(O + row * 512 + lane * 8 + 4); gr[r] = *(const uint4*)(Z + row * ZW + 2560 + lane * 8); }
#pragma unroll
    for (int r = 0; r < 4; ++r) ss[r] = (a[r][0] * a[r][0] + a[r][1] * a[r][1]) + (a[r][2] * a[r][2] + a[r][3] * a[r][3]) + (b2[r][0] * b2[r][0] + b2[r][1] * b2[r][1]) + (b2[r][2] * b2[r][2] + b2[r][3] * b2[r][3]);
#pragma unroll
    for (int o = 1; o < 16; o <<= 1) {
#pragma unroll
      for (int r = 0; r < 4; ++r) ss[r] += __shfl_xor(ss[r], o);
    }
#pragma unroll
    for (int r = 0; r < 4; ++r) { const size_t row = (size_t)row0 + (size_t)r * nw;
      const float rs = rsqrtf(ss[r] * (1.f / 128.f) + 1e-6f);
      float gt[8]; unpack8(gr[r], gt);
      float v[8] = {a[r][0], a[r][1], a[r][2], a[r][3], b2[r][0], b2[r][1], b2[r][2], b2[r][3]};
#pragma unroll
      for (int e = 0; e < 8; ++e) v[e] = v[e] * rs * gn[e] * siluf_(gt[e]);
      *(uint4*)(out + row * 512 + lane * 8) = pack8(v); }
  }
}

DEVI void phase_attn(int wv, PP p, unsigned char* shm) {
  const u16* Q = (const u16*)(p->ws + OFF_Q); const u16* KB = (const u16*)(p->ws + OFF_KB); const u16* VT = (const u16*)(p->ws + OFF_VT);
  u16* AO = (u16*)(p->ws + OFF_AO);
  u16* L = (u16*)shm;
  for (int u = blockIdx.x; u < 512; u += gridDim.x) {
    const int tid = otid(wv), wid = tid >> 6, lane = tid & 63, fr = lane & 15, fq = lane >> 4;
    const int qt = u & 31, head = (u >> 5) & 3, b = u >> 7;
    const int q0 = b * 4096 + qt * 128 + wid * 16;
    {
      const u16* Kg = KB + (size_t)(b * 256) * 1024 + head * 256;
      uint4 tmp[16];
#pragma unroll
      for (int i = 0; i < 16; ++i) { const int it = tid + i * 512, r = it >> 5, c = (it & 31) * 8; tmp[i] = *(const uint4*)(Kg + (size_t)r * 1024 + c); }
#pragma unroll
      for (int i = 0; i < 16; ++i) { const int it = tid + i * 512, r = it >> 5, c = (it & 31) * 8; *(uint4*)(L + r * 264 + c) = tmp[i]; }
    }
    const u16* Qp = Q + (size_t)(q0 + fr) * 1024 + head * 256 + fq * 8;
    bf16x8 qf[8];
#pragma unroll
    for (int kk = 0; kk < 8; ++kk) qf[kk] = *(const bf16x8*)(Qp + kk * 32);
    __syncthreads();
    f32x4 sc[16];
#pragma unroll
    for (int mt = 0; mt < 16; ++mt) {
      f32x4 a = {0.f, 0.f, 0.f, 0.f};
#pragma unroll
      for (int kk = 0; kk < 8; ++kk) { const bf16x8 kfr = *(const bf16x8*)(L + (mt * 16 + fr) * 264 + kk * 32 + fq * 8); a = MFMA16(kfr, qf[kk], a); }
      sc[mt] = a;
      if ((mt & 3) == 3) __builtin_amdgcn_sched_barrier(0);
    }
    __syncthreads();
    uint4 vtmp[8];
    const u16* Vg = VT + (size_t)(b * 4 + head) * 65536;
#pragma unroll
    for (int i = 0; i < 8; ++i) { const int it = tid + i * 512, r = it >> 5, c = (it & 31) * 8; vtmp[i] = *(const uint4*)(Vg + (size_t)r * 256 + c); }
    float mx = -3.0e38f;
#pragma unroll
    for (int mt = 0; mt < 16; ++mt)
#pragma unroll
      for (int j = 0; j < 4; ++j) mx = fmaxf(mx, sc[mt][j]);
    mx = fmaxf(mx, __shfl_xor(mx, 16)); mx = fmaxf(mx, __shfl_xor(mx, 32));
    float sum = 0.f;
#pragma unroll
    for (int mt = 0; mt < 16; ++mt)
#pragma unroll
      for (int j = 0; j < 4; ++j) { const float e = exp2f((sc[mt][j] - mx) * (1.4426950408889634f / 16.f)); sum += e; sc[mt][j] = e; }
    sum += __shfl_xor(sum, 16); sum += __shfl_xor(sum, 32);
    const float inv = 1.f / sum;
    bf16x8 pf[8];
#pragma unroll
    for (int t2 = 0; t2 < 8; ++t2) { uint4 o; o.x = pk2(sc[2 * t2][0], sc[2 * t2][1]); o.y = pk2(sc[2 * t2][2], sc[2 * t2][3]); o.z = pk2(sc[2 * t2 + 1][0], sc[2 * t2 + 1][1]); o.w = pk2(sc[2 * t2 + 1][2], sc[2 * t2 + 1][3]); pf[t2] = as_bf8(o); }
#pragma unroll
    for (int i = 0; i < 8; ++i) { const int it = tid + i * 512, r = it >> 5, c = (it & 31) * 8; *(uint4*)(L + r * 264 + c) = vtmp[i]; }
#pragma unroll
    for (int i = 0; i < 8; ++i) { const int it = tid + (i + 8) * 512, r = it >> 5, c = (it & 31) * 8; vtmp[i] = *(const uint4*)(Vg + (size_t)r * 256 + c); }
#pragma unroll
    for (int i = 0; i < 8; ++i) { const int it = tid + (i + 8) * 512, r = it >> 5, c = (it & 31) * 8; *(uint4*)(L + r * 264 + c) = vtmp[i]; }
    __syncthreads();
    u16* op = AO + (size_t)(q0 + fr) * 1024 + head * 256 + fq * 4;
#pragma unroll
    for (int dt = 0; dt < 16; ++dt) {
      f32x4 o = {0.f, 0.f, 0.f, 0.f};
#pragma unroll
      for (int t2 = 0; t2 < 8; ++t2) { const bf16x8 vfr = *(const bf16x8*)(L + (dt * 16 + fr) * 264 + t2 * 32 + fq * 8); o = MFMA16(vfr, pf[t2], o); }
      uint2 st; st.x = pk2(o[0] * inv, o[1] * inv); st.y = pk2(o[2] * inv, o[3] * inv);
      *(uint2*)(op + dt * 16) = st;
      if ((dt & 3) == 3) __builtin_amdgcn_sched_barrier(0);
    }
    __syncthreads();
  }
}

#define XB_TMO      128
#define XB_XCNT(j)  (256  + 64 * (j))
#define XB_XSUB(j)  (1280 + 64 * (j))
#define XB_XGEN(j)  (2304 + 64 * (j))
#define XB_TOP      3328
#define XB_TOPGEN   3392
#define XCD_BAR_WORDS 3456
#define XB_SPIN_CAP (1u << 18)
#define XLAS __attribute__((address_space(3)))

__device__ __forceinline__ unsigned xb_ld(unsigned* p)              { return __hip_atomic_load(p, __ATOMIC_RELAXED, __HIP_MEMORY_SCOPE_AGENT); }
__device__ __forceinline__ unsigned xb_add(unsigned* p, unsigned v) { return __hip_atomic_fetch_add(p, v, __ATOMIC_RELAXED, __HIP_MEMORY_SCOPE_AGENT); }
__device__ __forceinline__ unsigned xb_xcc_id() { return (unsigned)__builtin_amdgcn_s_getreg((3 << 11) | 20) & 0xFu; }
#define XB_SPIN(cond, bar) do { unsigned _sp = 0; while (cond) { __builtin_amdgcn_s_sleep(1); \
    if ((++_sp & 255u) == 0u) { if (xb_ld(&(bar)[XB_TMO])) break; if (_sp > XB_SPIN_CAP) { atomicAdd(&(bar)[XB_TMO], 1u); break; } } } } while (0)

struct XcdBarrier {
    int wv; unsigned* bar; unsigned x;
    volatile XLAS unsigned* st;
};

__device__ __forceinline__ XcdBarrier xcd_barrier_post(int wv, unsigned* bar, volatile XLAS unsigned* st) {
    XcdBarrier b; b.wv = wv; b.bar = bar; b.x = xb_xcc_id(); b.st = st;
    if (wv == 0 && lane_id() == 0) (void)xb_add(&bar[XB_XCNT(b.x)], 1u);
    return b;
}
__device__ __forceinline__ void xcd_barrier_complete(unsigned* bar, unsigned x, unsigned& nloc, unsigned& nx) {
    const unsigned G = gridDim.x * gridDim.y * gridDim.z;
    unsigned sum, cnt, mine, sp = 0u;
    for (;;) {
        sum = 0u; cnt = 0u; mine = 0u;
#pragma unroll
        for (unsigned j = 0; j < 16; ++j) { const unsigned c = xb_ld(&bar[XB_XCNT(j)]); sum += c; cnt += (c > 0u) ? 1u : 0u; mine = (j == x) ? c : mine; }
        if (sum == G) break;
        __builtin_amdgcn_s_sleep(1);
        if ((++sp & 255u) == 0u) { if (xb_ld(&bar[XB_TMO])) break; if (sp > XB_SPIN_CAP) { atomicAdd(&bar[XB_TMO], 1u); break; } }
    }
    nloc = mine > 0u ? mine : 1u; nx = cnt > 0u ? cnt : 1u;
}

__device__ __forceinline__ void xcd_barrier(const XcdBarrier& b) {
    asm volatile("s_waitcnt vmcnt(0)" ::: "memory");
    __syncthreads();
    if (b.wv == 0 && lane_id() == 0) {
        unsigned* bar = b.bar;
        __builtin_amdgcn_s_waitcnt(0);
        unsigned nloc = b.st[0], nx = b.st[1];
        if (nloc == 0u) { xcd_barrier_complete(bar, b.x, nloc, nx); b.st[0] = nloc; b.st[1] = nx; }
        const unsigned old = xb_add(&bar[XB_XSUB(b.x)], 1u);
        const unsigned gen = old / nloc;
        if (old + 1u == (gen + 1u) * nloc) {
            __builtin_amdgcn_fence(__ATOMIC_RELEASE, "agent");
            asm volatile("s_waitcnt vmcnt(0)" ::: "memory");
            const unsigned og = xb_add(&bar[XB_TOP], 1u);
            const unsigned tg = og / nx;
            if (og + 1u == (tg + 1u) * nx) xb_add(&bar[XB_TOPGEN], 1u);
            else XB_SPIN(xb_ld(&bar[XB_TOPGEN]) == tg, bar);
            __builtin_amdgcn_fence(__ATOMIC_ACQUIRE, "agent");
            xb_add(&bar[XB_XGEN(b.x)], 1u);
            asm volatile("s_waitcnt vmcnt(0)" ::: "memory");
        } else {
            XB_SPIN(xb_ld(&bar[XB_XGEN(b.x)]) == gen, bar);
            __builtin_amdgcn_fence(__ATOMIC_ACQUIRE, "agent");
            asm volatile("s_waitcnt vmcnt(0)" ::: "memory");
        }
    }
    __syncthreads();
}

#ifndef PROBE_ID
#define PROBE_ID 0
#endif
#define REPS(id) (PROBE_ID == (id) ? 3 : 1)
__global__ void __launch_bounds__(512, 2) mega(Params p_unused) {
  PP p = (PP)__builtin_amdgcn_kernarg_segment_ptr();
  extern __shared__ __attribute__((aligned(16))) unsigned char shm[];
  cg::grid_group grid = cg::this_grid();
  unsigned char* ws = p->ws;
  const int bid = blockIdx.x, G = gridDim.x;
  const int wv = __builtin_amdgcn_readfirstlane((int)threadIdx.x >> 6);
  if (G == 0x7fffffff) grid.sync();
  volatile XLAS unsigned* xst = (volatile XLAS unsigned*)(shm + LDS_BYTES - 16);
  if (wv == 0 && lane_id() == 0) { xst[0] = 0u; xst[1] = 0u; }
  __syncthreads();
  XcdBarrier xb = xcd_barrier_post(wv, (unsigned*)(ws + OFF_BAR), xst);
#ifdef PROBE_A
  float* tacc = (float*)(shm + LDS_BYTES - 128); unsigned long long* tsp = (unsigned long long*)(shm + LDS_BYTES - 48);
  if (threadIdx.x == 0) { for (int i = 0; i < 16; ++i) tacc[i] = 0.f; *tsp = wall_clock64(); }
#define GSYNC(id) do { xcd_barrier(xb); if (threadIdx.x == 0) { const unsigned long long t_ = wall_clock64(); tacc[id] += (float)(t_ - *tsp) * 0.01f; *tsp = t_; } } while (0)
#else
#define GSYNC(id) xcd_barrier(xb)
#endif
#pragma unroll 1
  for (int l = 0; l < DEPTH; ++l) {
    unsigned char* ws = opq(p)->ws;
    for (int rp = 0; rp < REPS(10); ++rp) { if (rp) GSYNC(0); phase_prep(wv, opq(p), l, shm); }
    GSYNC(0);
    { EpiStore<0> E; E.O = (u16*)(ws + OFF_Z); E.ldc = ZW; run_gemm(wv, shm, (const u16*)(ws + OFF_HM), (const u16*)(ws + OFF_WT_IN), T, ZW, 1024, E); }
    GSYNC(1);
    for (int rp = 0; rp < REPS(2); ++rp) {
    if (rp) GSYNC(2);
    for (int r12 = 0; r12 < REPS(12); ++r12) for (int u = bid; u < 512; u += G) unit_conv(wv, opq(p), l, u, shm);
    for (int r13 = 0; r13 < REPS(13); ++r13) for (int u = bid; u < 512; u += G) unit_gmlp(wv, opq(p), l, u, shm);
    for (int r14 = 0; r14 < REPS(14); ++r14) for (int u = bid; u < 512; u += G) unit_pool(wv, opq(p), l, u, shm);
    for (int r11 = 0; r11 < REPS(11); ++r11) phase_dn_pre(wv, opq(p), l, shm);
    }
    GSYNC(2);
    for (int rp = 0; rp < REPS(3); ++rp) {
    if (rp) GSYNC(3);
    if (bid < 128) { for (int r5 = 0; r5 < REPS(5); ++r5) { phase_dn_scan(wv, opq(p), shm); __syncthreads(); } }
    else {
      { EpiMerge<1> E; E.Mg = (u16*)(ws + OFF_HM); E.Zg = (const u16*)(ws + OFF_Z) + 4608; run_gemm_sub(wv, shm, (const u16*)(ws + OFF_BR), (const u16*)(ws + OFF_WT_BR), T, 1024, 512, E, G - 128, bid - 128); }
#pragma unroll 1
      for (int i = 2; i < 4; ++i) { EpiMerge<0> E; E.Mg = (u16*)(ws + OFF_HM); E.Zg = (const u16*)(ws + OFF_Z) + 4608 + i * 1024;
        run_gemm_sub(wv, shm, (const u16*)(ws + OFF_BR) + (size_t)i * T * 512, (const u16*)(ws + OFF_WT_BR) + (size_t)i * 1024 * 512, T, 1024, 512, E, G - 128, bid - 128); }
    }
    }
    GSYNC(3);
    for (int r4 = 0; r4 < REPS(4); ++r4) phase_dn_post(wv, opq(p), l);
    for (int r16 = 0; r16 < REPS(16); ++r16) { EpiKV E; E.Kb = (u16*)(ws + OFF_KB); E.Vt = (u16*)(ws + OFF_VT); run_gemm(wv, shm, (const u16*)(ws + OFF_MEMN), (const u16*)(ws + OFF_WT_KV), 1024, 2048, 1024, E); }
    GSYNC(4);
    { EpiMerge<0> E; E.Mg = (u16*)(ws + OFF_HM); E.Zg = (const u16*)(ws + OFF_Z) + 4608 + 1024;
      run_gemm(wv, shm, (const u16*)(ws + OFF_BR) + (size_t)T * 512, (const u16*)(ws + OFF_WT_BR) + (size_t)1024 * 512, T, 1024, 512, E); }
    GSYNC(5);
    { EpiResid E; E.X = opq(p)->out; E.ldc = 1024; run_gemm(wv, shm, (const u16*)(ws + OFF_HM), (const u16*)(ws + OFF_WT_OUT), T, 1024, 1024, E); }
    GSYNC(6);
    for (int r7 = 0; r7 < REPS(7); ++r7) phase_norm(wv, opq(p), p->norm_xa + l * 1024, shm);
    GSYNC(7);
    { EpiStore<0> E; E.O = (u16*)(ws + OFF_Q); E.ldc = 1024; run_gemm(wv, shm, (const u16*)(ws + OFF_HM), (const u16*)(ws + OFF_WT_Q), T, 1024, 1024, E); }
    GSYNC(8);
    for (int rp = 0; rp < REPS(9); ++rp) { if (rp) GSYNC(9); phase_attn(wv, opq(p), shm); }
    GSYNC(9);
    { EpiResid E; E.X = opq(p)->out; E.ldc = 1024; run_gemm(wv, shm, (const u16*)(ws + OFF_AO), (const u16*)(ws + OFF_WT_O), T, 1024, 1024, E); }
    GSYNC(10);
    phase_norm(wv, opq(p), p->norm_mlp + l * 1024, shm);
    GSYNC(11);
    { EpiStore<1> E; E.O = (u16*)(ws + OFF_HID); E.ldc = FF; run_gemm(wv, shm, (const u16*)(ws + OFF_HM), (const u16*)(ws + OFF_WT_1), T, FF, 1024, E); }
    GSYNC(12);
    { EpiResid E; E.X = opq(p)->out; E.ldc = 1024; run_gemm(wv, shm, (const u16*)(ws + OFF_HID), (const u16*)(ws + OFF_WT_2), T, 1024, FF, E); }
    GSYNC(13);
  }
  phase_final(wv, opq(p));
#ifdef PROBE_A
  if (bid == 0) { __syncthreads(); if (threadIdx.x == 0) p->out[0] += tacc[PROBE_A]; const float bv = tacc[PROBE_B] * 0.1f; __syncthreads(); for (int i = threadIdx.x; i < 65536; i += 512) p->out[1024 + i] += bv; }
#endif
}

extern "C" void kernel_launch(void* const* d_in, const int* in_sizes, int n_in, void* d_out, int out_size,
                              void* d_ws, size_t ws_size, hipStream_t stream) {
  static int grid_blocks = 0;
  if (!grid_blocks) {
    int dev = 0, cus = 0, per_cu = 0;
    (void)hipGetDevice(&dev);
    (void)hipDeviceGetAttribute(&cus, hipDeviceAttributeMultiprocessorCount, dev);
    (void)hipFuncSetAttribute((const void*)mega, hipFuncAttributeMaxDynamicSharedMemorySize, LDS_BYTES);
    (void)hipOccupancyMaxActiveBlocksPerMultiprocessor(&per_cu, (const void*)mega, 512, (size_t)LDS_BYTES);
    if (n_in != 29 || ws_size < WS_END || per_cu < 1 || cus < 136) fprintf(stderr, "kernel_launch: unexpected configuration n_in %d ws %zu (need %zu) per_cu %d cus %d\n", n_in, ws_size, (size_t)WS_END, per_cu, cus);
    grid_blocks = cus > 256 ? 256 : cus;
  }
  Params p{};
  const float** pp = (const float**)&p;
  for (int i = 0; i < 29; ++i) pp[i] = (const float*)d_in[i];
  p.out = (float*)d_out; p.ws = (unsigned char*)d_ws;
  (void)hipMemsetAsync((unsigned char*)d_ws + OFF_BAR, 0, 16384, stream);
  void* args[] = {&p};
  hipError_t e = hipLaunchCooperativeKernel((void*)mega, dim3(grid_blocks), dim3(512), args, (size_t)LDS_BYTES, stream);
  if (e != hipSuccess) fprintf(stderr, "cooperative launch failed: %s (grid %d)\n", hipGetErrorString(e), grid_blocks);
}
```

```cpp
#include <hip/hip_runtime.h>
#include <hip/hip_cooperative_groups.h>
#include <cstdio>
namespace cg = cooperative_groups;
namespace pg8 {
#define PG8_LAS __attribute__((address_space(3)))
typedef unsigned short bf16_t;
typedef short bf16x8 __attribute__((ext_vector_type(8)));
typedef float f32x4 __attribute__((ext_vector_type(4)));
typedef unsigned u32x4 __attribute__((ext_vector_type(4)));
constexpr int BM = 256, BK = 64, HALF = 128, HTB = HALF * BK * 2  , STAGE_BYTES = 8 * HTB, NXCD = 8, WGM = 8;

__host__ __device__ __forceinline__ int lds_byte(int r, int c) { const int st = (r >> 4) * 2 + (c >> 5), rr = r & 15, cc = c & 31, ob = rr * 64 + cc * 2; return st * 1024 + (ob ^ (((ob >> 9) & 1) << 5)); }
__host__ __device__ __forceinline__ void stage_rc(int b, int& R, int& C) { const int st = b / 1024, sb = b % 1024, swz = sb ^ (((sb >> 9) & 1) << 5); R = (st >> 1) * 16 + swz / 64; C = (st & 1) * 32 + (swz % 64) / 2; }
__host__ __device__ __forceinline__ int perm32(int rho) { const int n = rho >> 4, i = rho & 15; return 8 * (i >> 2) + 4 * n + (i & 3); }

struct Unit { int pm, pn; };
struct Gemm { const bf16_t* A; const bf16_t* Bt; int M, N, K; };

struct StaticOrder {
    int nM, nN, nwg, G, c;
    __host__ __device__ void init(int M, int N, int G_, int c_) { nM = M / BM; nN = N / BM; nwg = nM * nN; G = G_; c = c_; }
    __host__ __device__ bool next(int i, Unit& u) const {
        const long L = (long)i * G + c; if (L >= nwg) return false;
        int wgid = (int)L; { const int q = nwg / NXCD, r = nwg % NXCD, xcd = wgid % NXCD, off = wgid / NXCD; wgid = (xcd < r ? xcd * (q + 1) : r * (q + 1) + (xcd - r) * q) + off; }
        const int nig = WGM * nN, gid = wgid / nig, fm = gid * WGM, gsz = (nM - fm) < WGM ? (nM - fm) : WGM;
        u.pm = fm + ((wgid % nig) % gsz); u.pn = (wgid % nig) / gsz; return true;
    }
    __device__ __forceinline__ void a_ready(const Unit&) const {}
    __device__ __forceinline__ void done(const Unit&) const {}
};
__device__ __forceinline__ unsigned cvt_pk_bf16(float lo, float hi) { unsigned r; asm("v_cvt_pk_bf16_f32 %0, %1, %2" : "=v"(r) : "v"(lo), "v"(hi)); return r; }
template <class Epi, class Sched, bool STAMP = false>
__device__ __forceinline__ void gemm_phase(PG8_LAS unsigned char* lds, const Gemm g, const Sched& S, const Epi& E, unsigned long long* stamps, int wv_) {
    int tid_ = (wv_ << 6) | (int)__builtin_amdgcn_mbcnt_hi(~0u, __builtin_amdgcn_mbcnt_lo(~0u, 0u)); asm volatile("" : "+v"(tid_)); const int tid = tid_, wid = __builtin_amdgcn_readfirstlane(tid >> 6), lane = tid & 63, wr = wid >> 2, wc = wid & 3, fr = lane & 15, fq = lane >> 4;
    const int K = g.K, nt = K / BK;
    int ts_lo = 0, ts_hi = 0, nts = 0; const unsigned long long rt_entry = STAMP ? (unsigned long long)wall_clock64() : 0ull;
#define PG8_STAMP() do { if (STAMP && wid == 0 && nts < 64) { const unsigned long long _c = (unsigned long long)clock64(); \
        ts_lo = (lane == nts) ? (int)(unsigned)_c : ts_lo; ts_hi = (lane == nts) ? (int)(unsigned)(_c >> 32) : ts_hi; ++nts; } } while (0)
    PG8_STAMP();
    unsigned voffA[2], voffB[2];
#pragma unroll
    for (int i = 0; i < 2; ++i) { int R, C; stage_rc(tid * 16 + i * 8192, R, C); const int Rb = Epi::PERM ? ((R & ~31) + perm32(R & 31)) : R;
        voffA[i] = (unsigned)(R * K + C) * 2u; voffB[i] = (unsigned)(Rb * K + C) * 2u; }
    const size_t kstep = (size_t)(BK * 2);
    const size_t hstep = (size_t)HALF * K * 2;
    const size_t tstep = 2 * hstep;
    const unsigned ldsw = (unsigned)wid * 1024u;
    const int aoff = lds_byte(wr * 64 + fr, fq * 8), boff = lds_byte(wc * 32 + fr, fq * 8);
#define PG8_SA(b, h) (((b) * 2 + (h)) * HTB)
#define PG8_SB(b, h) ((4 + (b) * 2 + (h)) * HTB)
#define PG8_STAGE(bufoff, gbase, voff) do { _Pragma("unroll") for (int _i = 0; _i < 2; ++_i) \
        __builtin_amdgcn_global_load_lds((const unsigned*)((const char*)(gbase) + (voff)[_i]), (PG8_LAS unsigned*)(lds + (bufoff) + ldsw + _i * 8192), 16, 0, 0); } while (0)
#define PG8_LDA(dst, b, h) do { _Pragma("unroll") for (int m = 0; m < 4; ++m) _Pragma("unroll") for (int k = 0; k < 2; ++k) dst[m][k] = *(const PG8_LAS bf16x8*)(lds + PG8_SA(b, h) + aoff + m * 2048 + k * 1024); } while (0)
#define PG8_LDB(dst, b, h) do { _Pragma("unroll") for (int n = 0; n < 2; ++n) _Pragma("unroll") for (int k = 0; k < 2; ++k) dst[n][k] = *(const PG8_LAS bf16x8*)(lds + PG8_SB(b, h) + boff + n * 2048 + k * 1024); } while (0)
#define PG8_MMA(ai, bj, At, Bt) do { __builtin_amdgcn_s_setprio(1); _Pragma("unroll") for (int m = 0; m < 4; ++m) _Pragma("unroll") for (int n = 0; n < 2; ++n) _Pragma("unroll") for (int k = 0; k < 2; ++k) \
        acc[ai][bj][m][n] = __builtin_amdgcn_mfma_f32_16x16x32_bf16(Bt[n][k], At[m][k], acc[ai][bj][m][n], 0, 0, 0); __builtin_amdgcn_s_setprio(0); } while (0)
#define PG8_WAIT_V(n) asm volatile("s_waitcnt vmcnt(" #n ")" ::: "memory")
#define PG8_WAIT_L(n) asm volatile("s_waitcnt lgkmcnt(" #n ")" ::: "memory")
#define PG8_BAR __builtin_amdgcn_s_barrier()
#define PG8_SCHED __builtin_amdgcn_sched_barrier(0)
    Unit cur, nxt; int ui = 0;
    if (!S.next(0, cur)) return;
    f32x4 acc[2][2][4][2];
    E.init(acc, cur, wr, wc, fr, fq);
    bf16x8 At[4][2], B0[2][2], B1[2][2];
    const char* cA = (const char*)g.A + (size_t)cur.pm * tstep; const char* cB = (const char*)g.Bt + (size_t)cur.pn * tstep;
    S.a_ready(cur);
    PG8_STAGE(PG8_SB(0, 0), cB, voffB); PG8_STAGE(PG8_SA(0, 0), cA, voffA); PG8_STAGE(PG8_SB(0, 1), cB + hstep, voffB); PG8_STAGE(PG8_SA(0, 1), cA + hstep, voffA);
    if (wr == 1) PG8_BAR;
    PG8_WAIT_V(4); PG8_BAR;
    PG8_STAGE(PG8_SB(1, 0), cB + kstep, voffB); PG8_STAGE(PG8_SA(1, 0), cA + kstep, voffA); PG8_STAGE(PG8_SB(1, 1), cB + hstep + kstep, voffB);
    PG8_WAIT_V(6); PG8_BAR;
    PG8_STAMP();
    for (;;) {
        const bool has_next = S.next(ui + 1, nxt);
        const char* nA = has_next ? (const char*)g.A + (size_t)nxt.pm * tstep : cA; const char* nB = has_next ? (const char*)g.Bt + (size_t)nxt.pn * tstep : cB;
        for (int t = 0; t < nt; t += 2) {
            const bool last = (t == nt - 2);
            const char* a1 = cA + (size_t)(t + 1) * kstep;
            const char* a2 = last ? nA : cA + (size_t)(t + 2) * kstep; const char* b2 = last ? nB : cB + (size_t)(t + 2) * kstep;
            const char* a3 = a2 + kstep; const char* b3 = b2 + kstep;
            if (last && has_next) S.a_ready(nxt);
            PG8_LDB(B0, 0, 0); PG8_SCHED; PG8_LDA(At, 0, 0); PG8_STAGE(PG8_SA(1, 1), a1 + hstep, voffA);
            PG8_WAIT_L(8); PG8_BAR; PG8_WAIT_L(0); PG8_MMA(0, 0, At, B0); PG8_BAR; PG8_SCHED;
            PG8_LDB(B1, 0, 1); PG8_STAGE(PG8_SB(0, 0), b2, voffB);
            PG8_BAR; PG8_WAIT_L(0); PG8_MMA(0, 1, At, B1); PG8_BAR;
            PG8_LDA(At, 0, 1); PG8_STAGE(PG8_SA(0, 0), a2, voffA);
            PG8_BAR; PG8_WAIT_L(0); PG8_MMA(1, 0, At, B0); PG8_BAR; PG8_SCHED;
            PG8_STAGE(PG8_SB(0, 1), b2 + hstep, voffB);
            PG8_WAIT_V(6); PG8_BAR; PG8_MMA(1, 1, At, B1); PG8_BAR;
            PG8_LDB(B0, 1, 0); PG8_SCHED; PG8_LDA(At, 1, 0); PG8_STAGE(PG8_SA(0, 1), a2 + hstep, voffA);
            PG8_WAIT_L(8); PG8_BAR; PG8_WAIT_L(0); PG8_MMA(0, 0, At, B0); PG8_BAR; PG8_SCHED;
            PG8_LDB(B1, 1, 1); PG8_STAGE(PG8_SB(1, 0), b3, voffB);
            PG8_BAR; PG8_WAIT_L(0); PG8_MMA(0, 1, At, B1); PG8_BAR;
            PG8_LDA(At, 1, 1); PG8_STAGE(PG8_SA(1, 0), a3, voffA);
            PG8_BAR; PG8_WAIT_L(0); PG8_MMA(1, 0, At, B0); PG8_BAR; PG8_SCHED;
            PG8_STAGE(PG8_SB(1, 1), b3 + hstep, voffB);
            PG8_WAIT_V(6); PG8_BAR; PG8_MMA(1, 1, At, B1); PG8_BAR;
        }
        PG8_STAMP();
        if constexpr (!Epi::AFTER_DRAIN) { E(acc, cur, wr, wc, fr, fq); S.done(cur); }
        PG8_STAMP();
        if (!has_next) break;
        cur = nxt; cA = nA; cB = nB; ++ui;
        E.init(acc, cur, wr, wc, fr, fq);
    }
    PG8_WAIT_V(0);
    if (wr == 0) PG8_BAR;
    PG8_BAR;
    if constexpr (Epi::AFTER_DRAIN) { E.fused(acc, cur, wr, wc, fr, fq, lds, wid, lane); S.done(cur); }
    PG8_STAMP();
    if (STAMP && wid == 0) { stamps[lane] = lane < nts ? (((unsigned long long)(unsigned)ts_hi << 32) | (unsigned)ts_lo) : 0ull;
        if (lane == 62) stamps[62] = rt_entry; if (lane == 63) stamps[63] = (unsigned long long)wall_clock64(); }
#undef PG8_STAMP
#undef PG8_SA
#undef PG8_SB
#undef PG8_STAGE
#undef PG8_LDA
#undef PG8_LDB
#undef PG8_MMA
#undef PG8_WAIT_V
#undef PG8_WAIT_L
#undef PG8_BAR
#undef PG8_SCHED
}
}

#include <cstdio>
#include <ctime>
#include <cstdlib>
#include <cstring>
#include <cmath>
#include <vector>
#include <algorithm>
#define CK(x) do { hipError_t e_ = (x); if (e_ != hipSuccess) { fprintf(stderr, "HIP %s:%d %s\n", __FILE__, __LINE__, hipGetErrorString(e_)); exit(2); } } while (0)


typedef unsigned short u16;
typedef pg8::bf16x8 bf16x8;
typedef pg8::f32x4 f32x4;
#define DEVI __device__ __forceinline__
#define MFMA16(a, b, c) __builtin_amdgcn_mfma_f32_16x16x32_bf16((a), (b), (c), 0, 0, 0)

constexpr int T = 16384, DM = 1024, SEQ = 4096, ZW = 8960, INW = 8712, FF = 4096, DEPTH = 4;
constexpr int LDS_BYTES = 147456;

constexpr size_t OFF_WT_IN = 0;
constexpr size_t OFF_WT_BR = OFF_WT_IN + (size_t)ZW * 1024 * 2;
constexpr size_t OFF_WT_OUT = OFF_WT_BR + (size_t)4 * 1024 * 512 * 2;
constexpr size_t OFF_WT_Q = OFF_WT_OUT + (size_t)1024 * 1024 * 2;
constexpr size_t OFF_WT_KV = OFF_WT_Q + (size_t)1024 * 1024 * 2;
constexpr size_t OFF_WT_O = OFF_WT_KV + (size_t)2048 * 1024 * 2;
constexpr size_t OFF_WT_1 = OFF_WT_O + (size_t)1024 * 1024 * 2;
constexpr size_t OFF_WT_2 = OFF_WT_1 + (size_t)4096 * 1024 * 2;
constexpr size_t OFF_POOLT = OFF_WT_2 + (size_t)4096 * 1024 * 2;
constexpr size_t OFF_Z = OFF_POOLT + (size_t)4 * 128 * 128 * 2;
constexpr size_t OFF_HM = OFF_Z + (size_t)T * ZW * 2;
constexpr size_t OFF_BR = OFF_HM + (size_t)T * 1024 * 2;
constexpr size_t OFF_U = OFF_BR + (size_t)4 * T * 512 * 2;
constexpr size_t OFF_W = OFF_U + (size_t)1024 * 64 * 128 * 2;
constexpr size_t OFF_QD = OFF_W + (size_t)1024 * 64 * 128 * 2;
constexpr size_t OFF_KDT = OFF_QD + (size_t)1024 * 64 * 128 * 2;
constexpr size_t OFF_ATT = OFF_KDT + (size_t)1024 * 64 * 128 * 2;
constexpr size_t OFF_GL = OFF_ATT + (size_t)1024 * 64 * 64 * 2;
constexpr size_t OFF_O = OFF_GL + 4096;
constexpr size_t OFF_BD = OFF_O + (size_t)T * 512 * 4;
constexpr size_t OFF_KB = OFF_BD + (size_t)T * 8 * 4;
constexpr size_t OFF_VT = OFF_KB + (size_t)1024 * 1024 * 2;
constexpr size_t OFF_MEMN = OFF_VT + (size_t)1024 * 1024 * 2;
constexpr size_t OFF_BAR = OFF_MEMN + (size_t)1024 * 1024 * 2;
constexpr size_t WS_END = OFF_BAR + 16384;
static_assert(WS_END <= (size_t)4 * 4 * 1024 * INW * 4, "workspace too large");
constexpr size_t OFF_Q = OFF_Z;
constexpr size_t OFF_AO = OFF_Z + (size_t)T * 1024 * 2;
constexpr size_t OFF_HID = OFF_Z;

struct Params {
  const float *x, *mem, *norm_mix, *w_in, *conv_a_w, *conv_a_b, *ln_a_g, *ln_a_b, *dn_conv_w, *dn_a_log, *dn_dt_bias, *dn_norm_g,
      *gm_ln_g, *gm_ln_b, *gm_ws, *gm_bs, *pool_w, *pool_scale, *w_branch, *w_out, *norm_xa, *norm_mem, *xa_wq, *xa_wkv, *xa_wo,
      *norm_mlp, *mlp_w1, *mlp_w2, *norm_f;
  float* out;
  unsigned char* ws;
};

typedef const __attribute__((address_space(4))) Params* PP;
DEVI PP opq(PP p) { asm volatile("" : "+s"(p)); return p; }
DEVI int lane_id() { return (int)__builtin_amdgcn_mbcnt_hi(~0u, __builtin_amdgcn_mbcnt_lo(~0u, 0u)); }
DEVI int otid(int wv) { int t = (wv << 6) | lane_id(); asm volatile("" : "+v"(t)); return t; }
DEVI float bf2f(u16 b) { return __uint_as_float(((unsigned)b) << 16); }
DEVI float bflo(unsigned u) { return __uint_as_float(u << 16); }
DEVI float bfhi(unsigned u) { return __uint_as_float(u & 0xffff0000u); }
DEVI unsigned pk2(float lo, float hi) { return pg8::cvt_pk_bf16(lo, hi); }
DEVI u16 f2bf(float f) { return (u16)(pk2(f, f) & 0xffffu); }
DEVI void unpack8(uint4 r, float* v) { v[0] = bflo(r.x); v[1] = bfhi(r.x); v[2] = bflo(r.y); v[3] = bfhi(r.y); v[4] = bflo(r.z); v[5] = bfhi(r.z); v[6] = bflo(r.w); v[7] = bfhi(r.w); }
DEVI uint4 pack8(const float* v) { uint4 o; o.x = pk2(v[0], v[1]); o.y = pk2(v[2], v[3]); o.z = pk2(v[4], v[5]); o.w = pk2(v[6], v[7]); return o; }
DEVI bf16x8 as_bf8(uint4 u) { union { uint4 a; bf16x8 b; } c; c.a = u; return c.b; }
DEVI float sigmoidf_(float x) { return 1.f / (1.f + __expf(-x)); }
DEVI float siluf_(float x) { return x / (1.f + __expf(-x)); }
DEVI float geluf_(float v) {
  const float t = __builtin_amdgcn_rcpf(fabsf(v) * 0.2316418882f + 1.0f);
  float q = t * 0.5307027145f + (-0.7265760135f); q = q * t + 0.7107068705f; q = q * t + (-0.142248368f); q = q * t + 0.127414796f; q = q * t;
  const float e = __builtin_amdgcn_exp2f((v * v) * (-0.72134752044f));
  const float m = v * (q * e);
  return v < 0.f ? m : v - m;
}
DEVI float wave_sum(float v) {
#pragma unroll
  for (int o = 1; o < 64; o <<= 1) v += __shfl_xor(v, o);
  return v;
}
DEVI void lds_wait() { asm volatile("s_waitcnt lgkmcnt(0)" ::: "memory"); }
DEVI void lds_barrier() { asm volatile("s_waitcnt lgkmcnt(0)" ::: "memory"); __builtin_amdgcn_s_barrier(); asm volatile("" ::: "memory"); }

template <int ACT> struct EpiStore {
  static constexpr bool PERM = true, AFTER_DRAIN = false;
  u16* O; int ldc;
  DEVI void init(f32x4 (&acc)[2][2][4][2], const pg8::Unit&, int, int, int, int) const {
#pragma unroll
    for (int a = 0; a < 2; ++a)
#pragma unroll
      for (int b = 0; b < 2; ++b)
#pragma unroll
        for (int m = 0; m < 4; ++m)
#pragma unroll
          for (int n = 0; n < 2; ++n) acc[a][b][m][n] = (f32x4){0.f, 0.f, 0.f, 0.f};
  }
  DEVI void operator()(const f32x4 (&acc)[2][2][4][2], const pg8::Unit& u, int wr, int wc, int fr, int fq) const {
    const int row0 = u.pm * 256 + wr * 64 + fr, col0 = u.pn * 256 + wc * 32 + 8 * fq;
#pragma unroll
    for (int ai = 0; ai < 2; ++ai)
#pragma unroll
      for (int m = 0; m < 4; ++m) {
        u16* rowp = O + (size_t)(row0 + ai * 128 + m * 16) * ldc + col0;
#pragma unroll
        for (int bj = 0; bj < 2; ++bj) {
          f32x4 v0 = acc[ai][bj][m][0], v1 = acc[ai][bj][m][1];
          if (ACT == 1) {
#pragma unroll
            for (int e = 0; e < 4; ++e) { float a = fmaxf(v0[e], 0.f), b = fmaxf(v1[e], 0.f); v0[e] = a * a; v1[e] = b * b; }
          }
          uint4 o; o.x = pk2(v0[0], v0[1]); o.y = pk2(v0[2], v0[3]); o.z = pk2(v1[0], v1[1]); o.w = pk2(v1[2], v1[3]);
          *(uint4*)(rowp + bj * 128) = o;
        }
      }
  }
};
struct EpiResid {
  static constexpr bool PERM = false, AFTER_DRAIN = false;
  float* X; int ldc;
  DEVI void init(f32x4 (&acc)[2][2][4][2], const pg8::Unit& u, int wr, int wc, int fr, int fq) const {
    const int row0 = u.pm * 256 + wr * 64 + fr, col0 = u.pn * 256 + wc * 32 + 4 * fq;
#pragma unroll
    for (int ai = 0; ai < 2; ++ai)
#pragma unroll
      for (int m = 0; m < 4; ++m) {
        const float* rowp = X + (size_t)(row0 + ai * 128 + m * 16) * ldc + col0;
#pragma unroll
        for (int bj = 0; bj < 2; ++bj)
#pragma unroll
          for (int n = 0; n < 2; ++n) acc[ai][bj][m][n] = *(const f32x4*)(rowp + bj * 128 + n * 16);
      }
  }
  DEVI void operator()(const f32x4 (&acc)[2][2][4][2], const pg8::Unit& u, int wr, int wc, int fr, int fq) const {
    const int row0 = u.pm * 256 + wr * 64 + fr, col0 = u.pn * 256 + wc * 32 + 4 * fq;
#pragma unroll
    for (int ai = 0; ai < 2; ++ai)
#pragma unroll
      for (int m = 0; m < 4; ++m) {
        float* rowp = X + (size_t)(row0 + ai * 128 + m * 16) * ldc + col0;
#pragma unroll
        for (int bj = 0; bj < 2; ++bj)
#pragma unroll
          for (int n = 0; n < 2; ++n) *(f32x4*)(rowp + bj * 128 + n * 16) = acc[ai][bj][m][n];
      }
  }
};
template <int FIRST> struct EpiMerge {
  static constexpr bool PERM = true, AFTER_DRAIN = false;
  u16* Mg; const u16* Zg;
  DEVI void init(f32x4 (&acc)[2][2][4][2], const pg8::Unit&, int, int, int, int) const {
#pragma unroll
    for (int a = 0; a < 2; ++a)
#pragma unroll
      for (int b = 0; b < 2; ++b)
#pragma unroll
        for (int m = 0; m < 4; ++m)
#pragma unroll
          for (int n = 0; n < 2; ++n) acc[a][b][m][n] = (f32x4){0.f, 0.f, 0.f, 0.f};
  }
  DEVI void operator()(const f32x4 (&acc)[2][2][4][2], const pg8::Unit& u, int wr, int wc, int fr, int fq) const {
    const int row0 = u.pm * 256 + wr * 64 + fr, col0 = u.pn * 256 + wc * 32 + 8 * fq;
    uint4 gr[2][2], orr[2][2];
#pragma unroll
    for (int m2 = 0; m2 < 2; ++m2) { const size_t row = (size_t)(row0 + m2 * 16);
      gr[0][m2] = *(const uint4*)(Zg + row * ZW + col0); if (!FIRST) orr[0][m2] = *(const uint4*)(Mg + row * 1024 + col0); }
#pragma unroll
    for (int bt = 0; bt < 8; ++bt) {
      const int ai = bt >> 2, bj = (bt >> 1) & 1, mh = bt & 1, sl = bt & 1;
      if (bt < 7) { const int nai = (bt + 1) >> 2, nbj = ((bt + 1) >> 1) & 1, nmh = (bt + 1) & 1, ns = (bt + 1) & 1;
#pragma unroll
        for (int m2 = 0; m2 < 2; ++m2) { const size_t row = (size_t)(row0 + nai * 128 + (nmh * 2 + m2) * 16);
          gr[ns][m2] = *(const uint4*)(Zg + row * ZW + col0 + nbj * 128); if (!FIRST) orr[ns][m2] = *(const uint4*)(Mg + row * 1024 + col0 + nbj * 128); } }
#pragma unroll
      for (int m2 = 0; m2 < 2; ++m2) {
        const int m = mh * 2 + m2;
        const size_t row = (size_t)(row0 + ai * 128 + m * 16);
        float g[8], o[8];
        unpack8(gr[sl][m2], g);
        if (FIRST) {
#pragma unroll
          for (int e = 0; e < 8; ++e) o[e] = 0.f;
        } else unpack8(orr[sl][m2], o);
        const f32x4 v0 = acc[ai][bj][m][0], v1 = acc[ai][bj][m][1];
#pragma unroll
        for (int e = 0; e < 4; ++e) { o[e] += sigmoidf_(g[e]) * v0[e]; o[4 + e] += sigmoidf_(g[4 + e]) * v1[e]; }
        *(uint4*)(Mg + row * 1024 + col0 + bj * 128) = pack8(o);
      }
    }
  }
};
struct EpiKV {
  static constexpr bool PERM = false, AFTER_DRAIN = false;
  u16* Kb; u16* Vt;
  DEVI void init(f32x4 (&acc)[2][2][4][2], const pg8::Unit&, int, int, int, int) const {
#pragma unroll
    for (int a = 0; a < 2; ++a)
#pragma unroll
      for (int b = 0; b < 2; ++b)
#pragma unroll
        for (int m = 0; m < 4; ++m)
#pragma unroll
          for (int n = 0; n < 2; ++n) acc[a][b][m][n] = (f32x4){0.f, 0.f, 0.f, 0.f};
  }
  DEVI void operator()(const f32x4 (&acc)[2][2][4][2], const pg8::Unit& u, int wr, int wc, int fr, int fq) const {
    const int row0 = u.pm * 256 + wr * 64 + fr, col0 = u.pn * 256 + wc * 32 + 4 * fq;
#pragma unroll
    for (int ai = 0; ai < 2; ++ai)
#pragma unroll
      for (int m = 0; m < 4; ++m) {
        const int row = row0 + ai * 128 + m * 16;
#pragma unroll
        for (int bj = 0; bj < 2; ++bj)
#pragma unroll
          for (int n = 0; n < 2; ++n) {
            const int col = col0 + bj * 128 + n * 16; const f32x4 v = acc[ai][bj][m][n];
            if (u.pn < 4) { uint2 o; o.x = pk2(v[0], v[1]); o.y = pk2(v[2], v[3]); *(uint2*)(Kb + (size_t)row * 1024 + col) = o; }
            else { const int c2 = col - 1024, hh = c2 >> 8, d = c2 & 255, bb = row >> 8, mm = row & 255;
              const int pos = (mm & ~31) | (((mm >> 2) & 3) << 3) | (((mm >> 4) & 1) << 2) | (mm & 3);
              u16* vp = Vt + ((size_t)((bb * 4 + hh) * 256 + d)) * 256 + pos;
#pragma unroll
              for (int e = 0; e < 4; ++e) vp[(size_t)e * 256] = f2bf(v[e]); }
          }
      }
  }
};

template <class Epi> DEVI void run_gemm(int wv, unsigned char* shm, const u16* A, const u16* Bt, int M, int N, int K, const Epi& E) {
  pg8::StaticOrder S; S.init(M, N, (int)gridDim.x, (int)blockIdx.x);
  pg8::Gemm g; g.A = A; g.Bt = Bt; g.M = M; g.N = N; g.K = K;
  pg8::gemm_phase<Epi, pg8::StaticOrder, false>((PG8_LAS unsigned char*)shm, g, S, E, nullptr, wv);
}

template <class Epi> DEVI void run_gemm_sub(int wv, unsigned char* shm, const u16* A, const u16* Bt, int M, int N, int K, const Epi& E, int Gs, int c) {
  pg8::StaticOrder S; S.init(M, N, Gs, c);
  pg8::Gemm g; g.A = A; g.Bt = Bt; g.M = M; g.N = N; g.K = K;
  pg8::gemm_phase<Epi, pg8::StaticOrder, false>((PG8_LAS unsigned char*)shm, g, S, E, nullptr, wv);
}

DEVI void transpose_item(const float* W, int srcN, int n0s, int K, u16* WT, int n0d, int k0, float* scr, int lane) {
  float v[64];
#pragma unroll
  for (int i = 0; i < 64; ++i) v[i] = W[(size_t)(k0 + i) * srcN + n0s + lane];
#pragma unroll
  for (int i = 0; i < 64; ++i) scr[i * 65 + lane] = v[i];
  lds_wait();
  const int c = lane & 7;
#pragma unroll
  for (int j = 0; j < 8; ++j) { const int n = (lane >> 3) + 8 * j; const float* sp = scr + (8 * c) * 65 + n;
    uint4 o; o.x = pk2(sp[0 * 65], sp[1 * 65]); o.y = pk2(sp[2 * 65], sp[3 * 65]); o.z = pk2(sp[4 * 65], sp[5 * 65]); o.w = pk2(sp[6 * 65], sp[7 * 65]);
    *(uint4*)(WT + (size_t)(n0d + n) * K + k0 + 8 * c) = o; }
  lds_wait();
}

template <bool COPY, bool BDC> DEVI void rms_row(const float* xrow, const float* gain, u16* orow, float* copyrow, const float* wbd, float* bdrow, int lane) {
  const f32x4* xr = (const f32x4*)xrow + lane;
  f32x4 v[4]; float s = 0.f;
#pragma unroll
  for (int j = 0; j < 4; ++j) { v[j] = xr[64 * j]; s += (v[j][0] * v[j][0] + v[j][1] * v[j][1]) + (v[j][2] * v[j][2] + v[j][3] * v[j][3]); }
  if (COPY) {
#pragma unroll
    for (int j = 0; j < 4; ++j) ((f32x4*)copyrow)[lane + 64 * j] = v[j];
  }
  const float rstd = rsqrtf(wave_sum(s) * (1.f / 1024.f) + 1e-6f);
#pragma unroll
  for (int j = 0; j < 4; ++j) { const f32x4 g = ((const f32x4*)gain)[lane + 64 * j]; v[j] = v[j] * rstd * g; }
  uint2* o8 = (uint2*)orow + lane;
#pragma unroll
  for (int j = 0; j < 4; ++j) { uint2 o; o.x = pk2(v[j][0], v[j][1]); o.y = pk2(v[j][2], v[j][3]); o8[64 * j] = o; }
  if (BDC) {
    float a[8];
#pragma unroll
    for (int e = 0; e < 8; ++e) a[e] = 0.f;
#pragma unroll
    for (int j = 0; j < 4; ++j)
#pragma unroll
      for (int q = 0; q < 4; ++q) { const int k = 4 * (lane + 64 * j) + q; const f32x4 w0 = *(const f32x4*)(wbd + (size_t)k * INW), w1 = *(const f32x4*)(wbd + (size_t)k * INW + 4);
        const float hv = v[j][q];
        a[0] += hv * w0[0]; a[1] += hv * w0[1]; a[2] += hv * w0[2]; a[3] += hv * w0[3]; a[4] += hv * w1[0]; a[5] += hv * w1[1]; a[6] += hv * w1[2]; a[7] += hv * w1[3]; }
#pragma unroll
    for (int e = 0; e < 8; ++e) a[e] = wave_sum(a[e]);
    if (lane == 0) { f32x4 o0 = {a[0], a[1], a[2], a[3]}, o1 = {a[4], a[5], a[6], a[7]}; *(f32x4*)bdrow = o0; *(f32x4*)(bdrow + 4) = o1; }
  }
}


template <bool COPY> DEVI void rms_rows4(const float* xbase, size_t rstride, const float* gain, u16* obase, float* cbase, int lane) {
  f32x4 v[4][4]; float s[4];
#pragma unroll
  for (int r = 0; r < 4; ++r) { const f32x4* xr = (const f32x4*)(xbase + r * rstride) + lane;
#pragma unroll
    for (int j = 0; j < 4; ++j) v[r][j] = xr[64 * j]; }
#pragma unroll
  for (int r = 0; r < 4; ++r) { float a = 0.f;
#pragma unroll
    for (int j = 0; j < 4; ++j) a += (v[r][j][0] * v[r][j][0] + v[r][j][1] * v[r][j][1]) + (v[r][j][2] * v[r][j][2] + v[r][j][3] * v[r][j][3]);
    s[r] = a; }
  if (COPY) {
#pragma unroll
    for (int r = 0; r < 4; ++r)
#pragma unroll
      for (int j = 0; j < 4; ++j) ((f32x4*)(cbase + r * rstride))[lane + 64 * j] = v[r][j];
  }
#pragma unroll
  for (int o = 1; o < 64; o <<= 1) {
#pragma unroll
    for (int r = 0; r < 4; ++r) s[r] += __shfl_xor(s[r], o);
  }
  f32x4 g[4];
#pragma unroll
  for (int j = 0; j < 4; ++j) g[j] = ((const f32x4*)gain)[lane + 64 * j];
#pragma unroll
  for (int r = 0; r < 4; ++r) { const float rstd = rsqrtf(s[r] * (1.f / 1024.f) + 1e-6f); uint2* o8 = (uint2*)(obase + r * rstride) + lane;
#pragma unroll
    for (int j = 0; j < 4; ++j) { const f32x4 y = v[r][j] * rstd * g[j]; uint2 o; o.x = pk2(y[0], y[1]); o.y = pk2(y[2], y[3]); o8[64 * j] = o; } }
}

DEVI void phase_prep(int wv, PP p, int l, unsigned char* shm) {
  const int tid = otid(wv), wid = tid >> 6, lane = tid & 63;
  const int gw = blockIdx.x * 8 + wid, nw = gridDim.x * 8;
  float* scr = (float*)(shm + wid * 16640);
  unsigned char* ws = p->ws;
  const float* w_in = p->w_in + (size_t)l * 1024 * INW;
  for (int it = gw; it < 6048; it += nw) {
    int r = it;
    if (r < 2192) { const int kb = r / 137, n0 = (r % 137) * 64; transpose_item(w_in, INW, n0 >= 8704 ? 3072 : n0 + (n0 >= 3072 ? 8 : 0), 1024, (u16*)(ws + OFF_WT_IN), n0, kb * 64, scr, lane); continue; }
    r -= 2192;
    if (r < 512) { const int i = r >> 7; r &= 127; transpose_item(p->w_branch + ((size_t)l * 4 + i) * 512 * 1024, 1024, (r & 15) * 64, 512, (u16*)(ws + OFF_WT_BR) + (size_t)i * 1024 * 512, (r & 15) * 64, (r >> 4) * 64, scr, lane); continue; }
    r -= 512;
    if (r < 256) { transpose_item(p->w_out + (size_t)l * 1024 * 1024, 1024, (r & 15) * 64, 1024, (u16*)(ws + OFF_WT_OUT), (r & 15) * 64, (r >> 4) * 64, scr, lane); continue; }
    r -= 256;
    if (r < 256) { transpose_item(p->xa_wq + (size_t)l * 1024 * 1024, 1024, (r & 15) * 64, 1024, (u16*)(ws + OFF_WT_Q), (r & 15) * 64, (r >> 4) * 64, scr, lane); continue; }
    r -= 256;
    if (r < 512) { transpose_item(p->xa_wkv + (size_t)l * 1024 * 2048, 2048, (r & 31) * 64, 1024, (u16*)(ws + OFF_WT_KV), (r & 31) * 64, (r >> 5) * 64, scr, lane); continue; }
    r -= 512;
    if (r < 256) { transpose_item(p->xa_wo + (size_t)l * 1024 * 1024, 1024, (r & 15) * 64, 1024, (u16*)(ws + OFF_WT_O), (r & 15) * 64, (r >> 4) * 64, scr, lane); continue; }
    r -= 256;
    if (r < 1024) { transpose_item(p->mlp_w1 + (size_t)l * 1024 * 4096, 4096, (r & 63) * 64, 1024, (u16*)(ws + OFF_WT_1), (r & 63) * 64, (r >> 6) * 64, scr, lane); continue; }
    r -= 1024;
    if (r < 1024) { transpose_item(p->mlp_w2 + (size_t)l * 4096 * 1024, 1024, (r & 15) * 64, 4096, (u16*)(ws + OFF_WT_2), (r & 15) * 64, (r >> 4) * 64, scr, lane); continue; }
    r -= 1024;
    { const int g = r >> 2; r &= 3; transpose_item(p->pool_w + ((size_t)l * 4 + g) * 16384, 128, (r & 1) * 64, 128, (u16*)(ws + OFF_POOLT) + (size_t)g * 16384, (r & 1) * 64, (r >> 1) * 64, scr, lane); }
  }
  for (int row = gw; row < T; row += 4 * nw) {
    if (l == 0) rms_rows4<true>(p->x + (size_t)row * 1024, (size_t)nw * 1024, p->norm_mix + l * 1024, (u16*)(ws + OFF_HM) + (size_t)row * 1024, p->out + (size_t)row * 1024, lane);
    else rms_rows4<false>(p->out + (size_t)row * 1024, (size_t)nw * 1024, p->norm_mix + l * 1024, (u16*)(ws + OFF_HM) + (size_t)row * 1024, nullptr, lane);
  }
  for (int row = gw; row < 1024; row += nw)
    rms_row<false, false>(p->mem + (size_t)row * 1024, p->norm_mem + l * 1024, (u16*)(ws + OFF_MEMN) + (size_t)row * 1024, nullptr, nullptr, nullptr, lane);
}

DEVI void phase_norm(int wv, PP p, const float* gain, unsigned char* shm) {
  const int tid = otid(wv), wid = tid >> 6, lane = tid & 63;
  const int gw = blockIdx.x * 8 + wid, nw = gridDim.x * 8;
  for (int row = gw; row < T; row += 4 * nw)
    rms_rows4<false>(p->out + (size_t)row * 1024, (size_t)nw * 1024, gain, (u16*)(p->ws + OFF_HM) + (size_t)row * 1024, nullptr, lane);
}

DEVI void phase_final(int wv, PP p) {
  const int tid = otid(wv), wid = tid >> 6, lane = tid & 63;
  const int gw = blockIdx.x * 8 + wid, nw = gridDim.x * 8;
  f32x4 g[4];
#pragma unroll
  for (int j = 0; j < 4; ++j) g[j] = ((const f32x4*)p->norm_f)[lane + 64 * j];
  for (int row0 = gw; row0 < T; row0 += 4 * nw) {
    f32x4 v[4][4]; float s[4];
#pragma unroll
    for (int r = 0; r < 4; ++r) { const f32x4* xr = (const f32x4*)(p->out + ((size_t)row0 + (size_t)r * nw) * 1024) + lane;
#pragma unroll
      for (int j = 0; j < 4; ++j) v[r][j] = xr[64 * j]; }
#pragma unroll
    for (int r = 0; r < 4; ++r) { float acc = 0.f;
#pragma unroll
      for (int j = 0; j < 4; ++j) acc += (v[r][j][0] * v[r][j][0] + v[r][j][1] * v[r][j][1]) + (v[r][j][2] * v[r][j][2] + v[r][j][3] * v[r][j][3]);
      s[r] = acc; }
#pragma unroll
    for (int o = 1; o < 64; o <<= 1) {
#pragma unroll
      for (int r = 0; r < 4; ++r) s[r] += __shfl_xor(s[r], o);
    }
#pragma unroll
    for (int r = 0; r < 4; ++r) { const float rstd = rsqrtf(s[r] * (1.f / 1024.f) + 1e-6f); f32x4* xr = (f32x4*)(p->out + ((size_t)row0 + (size_t)r * nw) * 1024) + lane;
#pragma unroll
      for (int j = 0; j < 4; ++j) xr[64 * j] = v[r][j] * rstd * g[j]; }
  }
}

DEVI void phase_dn_pre(int wv, PP p, int l, unsigned char* shm) {
  unsigned char* ws = p->ws;
  const u16* Z = (const u16*)(ws + OFF_Z);
  const float* cwl = p->dn_conv_w + (size_t)l * 4 * 1536;
  const int nit = (gridDim.x == 256) ? 2 : (512 + (int)gridDim.x - 1 - (int)blockIdx.x) / (int)gridDim.x;
  for (int itp = 0; itp < nit; ++itp) {
    const int pu = (gridDim.x == 256) ? ((((int)(blockIdx.x & 7) >> 1) * 64 + ((int)(blockIdx.x >> 3) + 32 * (1 - itp))) * 2 + (int)(blockIdx.x & 1)) : ((int)blockIdx.x + itp * (int)gridDim.x);
    const int tid = otid(wv), half = tid >> 8, ht = tid & 255, hw = (tid >> 6) & 3, lane = tid & 63, fr = lane & 15, fq = lane >> 4;
    unsigned char* hb = shm + half * 70656;
    u16* qn = (u16*)hb; u16* kn = qn + 64 * 136; u16* vb = kn + 64 * 136;
    float* Am = (float*)(vb + 64 * 136); float* gam = Am + 64 * 68; float* bet = gam + 64; float* eg = bet + 64; float* ek = eg + 64;
    const int cidx = pu >> 1, h = (pu & 1) * 2 + half, b = cidx >> 6, n = cidx & 63;
    const int t0 = b * 4096 + n * 64, ch = cidx * 4 + h;
    {
      const int sub = ht & 15, i0 = (ht >> 4) * 4, sq0 = n * 64 + i0;
      const u16* zrow = Z + (size_t)(t0 + i0) * ZW;
#pragma unroll
      for (int ten = 0; ten < 3; ++ten) {
        const int zc = 1024 + ten * 512 + h * 128 + sub * 8;
        const float* cw = cwl + ten * 512 + h * 128 + sub * 8;
        uint4 raw[7]; f32x4 w0[4], w1[4];
#pragma unroll
        for (int r = 0; r < 7; ++r) { const int ro = (sq0 + r - 3 >= 0) ? (r - 3) : 0; raw[r] = *(const uint4*)(zrow + (ptrdiff_t)ro * ZW + zc); }
#pragma unroll
        for (int kk = 0; kk < 4; ++kk) { w0[kk] = *(const f32x4*)(cw + kk * 1536); w1[kk] = *(const f32x4*)(cw + kk * 1536 + 4); }
        float xr[7][8];
#pragma unroll
        for (int r = 0; r < 7; ++r) { unpack8(raw[r], xr[r]); const float mk = (sq0 + r - 3 >= 0) ? 1.f : 0.f;
#pragma unroll
          for (int e = 0; e < 8; ++e) xr[r][e] *= mk; }
#pragma unroll
        for (int tk = 0; tk < 4; ++tk) {
          float val[8]; float ss = 0.f;
#pragma unroll
          for (int e = 0; e < 8; ++e) {
            float a = 0.f;
#pragma unroll
            for (int kk = 0; kk < 4; ++kk) a += (e < 4 ? w0[kk][e & 3] : w1[kk][e & 3]) * xr[tk + kk][e];
            const float y = siluf_(a); val[e] = y; ss += y * y;
          }
          if (ten < 2) {
            ss += __shfl_xor(ss, 1); ss += __shfl_xor(ss, 2); ss += __shfl_xor(ss, 4); ss += __shfl_xor(ss, 8);
            const float sc = rsqrtf(ss + 1e-6f) * (ten == 0 ? 0.08838834764831845f : 1.f);
#pragma unroll
            for (int e = 0; e < 8; ++e) val[e] *= sc;
          }
          u16* dst = (ten == 0 ? qn : (ten == 1 ? kn : vb)) + (i0 + tk) * 136 + sub * 8;
          *(uint4*)dst = pack8(val);
        }
      }
    }
    if (hw == 0) {
      const u16* bd = Z + (size_t)(t0 + lane) * ZW + 8704;
      const float be = sigmoidf_(bf2f(bd[h]));
      const float xg = bf2f(bd[4 + h]) + p->dn_dt_bias[l * 4 + h];
      const float sp = xg > 20.f ? xg : log1pf(expf(xg));
      float g = -expf(p->dn_a_log[l * 4 + h]) * sp;
#pragma unroll
      for (int o = 1; o < 64; o <<= 1) { const float y = __shfl_up(g, o); if (lane >= o) g += y; }
      gam[lane] = g; bet[lane] = be; eg[lane] = expf(g); ek[lane] = expf(__shfl(g, 63) - g);
    }
    __syncthreads();
    {
      bf16x8 ak[4], aq[4];
#pragma unroll
      for (int ks = 0; ks < 4; ++ks) { ak[ks] = *(const bf16x8*)(kn + (hw * 16 + fr) * 136 + ks * 32 + fq * 8); aq[ks] = *(const bf16x8*)(qn + (hw * 16 + fr) * 136 + ks * 32 + fq * 8); }
      u16* att = (u16*)(ws + OFF_ATT) + (size_t)ch * 4096;
#pragma unroll
      for (int nt = 0; nt < 4; ++nt) {
        f32x4 ckk = {0.f, 0.f, 0.f, 0.f}, cqk = {0.f, 0.f, 0.f, 0.f};
        if (nt <= hw) {
#pragma unroll
          for (int ks = 0; ks < 4; ++ks) { const bf16x8 bfr = *(const bf16x8*)(kn + (nt * 16 + fr) * 136 + ks * 32 + fq * 8); ckk = MFMA16(ak[ks], bfr, ckk); cqk = MFMA16(aq[ks], bfr, cqk); }
        }
        const int jj = nt * 16 + fr; const float gj = gam[jj];
#pragma unroll
        for (int j = 0; j < 4; ++j) {
          const int i = hw * 16 + fq * 4 + j;
          const float dec = (i >= jj) ? __expf(gam[i] - gj) : 0.f;
          Am[i * 68 + jj] = (i > jj) ? bet[i] * ckk[j] * dec : 0.f;
          att[i * 64 + jj] = f2bf(cqk[j] * dec);
        }
      }
    }
    {
      const int i = ht >> 2, sub = ht & 3; const float egi = eg[i];
      u16* qd = (u16*)(ws + OFF_QD) + ((size_t)ch * 64 + i) * 128 + sub * 32;
#pragma unroll
      for (int c8 = 0; c8 < 4; ++c8) { float v[8]; unpack8(*(const uint4*)(qn + i * 136 + sub * 32 + c8 * 8), v);
#pragma unroll
        for (int e = 0; e < 8; ++e) v[e] *= egi;
        *(uint4*)(qd + c8 * 8) = pack8(v); }
      const int k = ht & 127, ih = ht >> 7;
      u16* kd = (u16*)(ws + OFF_KDT) + ((size_t)ch * 128 + k) * 64 + ih * 32;
#pragma unroll
      for (int c8 = 0; c8 < 4; ++c8) { float v[8];
#pragma unroll
        for (int e = 0; e < 8; ++e) { const int ii = ih * 32 + c8 * 8 + e; v[e] = bf2f(kn[ii * 136 + k]) * ek[ii]; }
        *(uint4*)(kd + c8 * 8) = pack8(v); }
      if (ht == 0) ((float*)(ws + OFF_GL))[ch] = eg[63];
    }
    __syncthreads();
    {
      const int col = ht; const bool isw = col >= 128;
      const u16* src = isw ? kn + (col - 128) : vb + col;
      float x[64]; int zo[64];
#pragma unroll
      for (int i = 0; i < 64; ++i) {
        const int zz = (i >= 2) ? zo[i - 2] : 0;
        float r = bf2f(src[i * 136 + zz]) * bet[i + zz]; if (isw) r *= eg[i + zz];
        const float* arow = Am + i * 68 + zz; float ra = 0.f, rb = 0.f;
#pragma unroll
        for (int j4 = 0; j4 < (i + 3) / 4; ++j4) {
          const f32x4 a = *(const f32x4*)(arow + j4 * 4);
#pragma unroll
          for (int e = 0; e < 4; ++e) if (j4 * 4 + e < i) { if (j4 & 1) rb += a[e] * x[j4 * 4 + e]; else ra += a[e] * x[j4 * 4 + e]; }
        }
        r -= ra + rb;
        x[i] = r;
        asm volatile("v_and_b32 %0, 0, %1" : "=v"(zo[i]) : "v"(__float_as_int(r)));
      }
      u16* dst = (u16*)(ws + (isw ? OFF_W : OFF_U)) + (size_t)ch * 8192 + (col & 127);
#pragma unroll
      for (int i = 0; i < 64; ++i) dst[i * 128] = f2bf(x[i]);
    }
    __syncthreads();
  }
}

DEVI void phase_dn_scan(int wv, PP p, unsigned char* shm) {
  const int tid = otid(wv), wid = tid >> 6, lane = tid & 63, fr = lane & 15, fq = lane >> 4;
  const int bid = blockIdx.x, xcd = bid & 7, idx = bid >> 3, stream = xcd * 2 + (idx >> 3), slice = idx & 7;
  const int b = stream >> 2, h = stream & 3, mt = wid & 3; const bool isV = wid < 4;
  unsigned char* ws = p->ws;
  u16* Sb = (u16*)shm; u16* Vb = Sb + 16 * 136;
  const u16* Abase = (const u16*)(ws + (isV ? OFF_W : OFF_QD));
  const u16* KDT = (const u16*)(ws + OFF_KDT); const u16* ATT = (const u16*)(ws + OFF_ATT); const u16* U = (const u16*)(ws + OFF_U);
  const float* GL = (const float*)(ws + OFF_GL); float* O = (float*)(ws + OFF_O);
  f32x4 sacc = {0.f, 0.f, 0.f, 0.f};
#define SCAN_LOAD(AF, KF, TF, UU, GLV, NIDX) do { const int ch_ = (b * 64 + (NIDX)) * 4 + h; \
    _Pragma("unroll") for (int ks = 0; ks < 4; ++ks) AF[ks] = *(const bf16x8*)(Abase + ((size_t)ch_ * 64 + mt * 16 + fr) * 128 + ks * 32 + fq * 8); \
    _Pragma("unroll") for (int ks = 0; ks < 2; ++ks) KF[ks] = *(const bf16x8*)(KDT + ((size_t)ch_ * 128 + wid * 16 + fr) * 64 + ks * 32 + fq * 8); \
    if (isV) { _Pragma("unroll") for (int j = 0; j < 4; ++j) UU[j] = U[((size_t)ch_ * 64 + mt * 16 + fq * 4 + j) * 128 + slice * 16 + fr]; \
      _Pragma("unroll") for (int ks = 0; ks < 2; ++ks) TF[ks] = (bf16x8){0, 0, 0, 0, 0, 0, 0, 0}; } \
    else { _Pragma("unroll") for (int ks = 0; ks < 2; ++ks) TF[ks] = *(const bf16x8*)(ATT + ((size_t)ch_ * 64 + mt * 16 + fr) * 64 + ks * 32 + fq * 8); \
      _Pragma("unroll") for (int j = 0; j < 4; ++j) UU[j] = 0; } \
    GLV = GL[ch_]; } while (0)
  bf16x8 af[4], kf[2], tf[2]; u16 uu[4]; float gl;
  bf16x8 af1[4], kf1[2], tf1[2]; u16 uu1[4]; float gl1;
  SCAN_LOAD(af, kf, tf, uu, gl, 0);
  SCAN_LOAD(af1, kf1, tf1, uu1, gl1, 1);
#pragma unroll 1
  for (int n = 0; n < 64; ++n) {
    const int nn = n < 62 ? n + 2 : 63;
    bf16x8 naf[4], nkf[2], ntf[2]; u16 nuu[4]; float ngl;
    SCAN_LOAD(naf, nkf, ntf, nuu, ngl, nn);
    { uint2 o; o.x = pk2(sacc[0], sacc[1]); o.y = pk2(sacc[2], sacc[3]); *(uint2*)(Sb + fr * 136 + wid * 16 + fq * 4) = o; }
    lds_barrier();
    f32x4 acc = {0.f, 0.f, 0.f, 0.f};
#pragma unroll
    for (int ks = 0; ks < 4; ++ks) { const bf16x8 sf = *(const bf16x8*)(Sb + fr * 136 + ks * 32 + fq * 8); acc = MFMA16(af[ks], sf, acc); }
    if (isV) { uint2 o; o.x = pk2(bf2f(uu[0]) - acc[0], bf2f(uu[1]) - acc[1]); o.y = pk2(bf2f(uu[2]) - acc[2], bf2f(uu[3]) - acc[3]); *(uint2*)(Vb + fr * 72 + mt * 16 + fq * 4) = o; }
    lds_barrier();
    const bf16x8 vf0 = *(const bf16x8*)(Vb + fr * 72 + fq * 8), vf1 = *(const bf16x8*)(Vb + fr * 72 + 32 + fq * 8);
    if (!isV) {
      acc = MFMA16(tf[0], vf0, acc); acc = MFMA16(tf[1], vf1, acc);
      const int t0 = b * 4096 + n * 64;
#pragma unroll
      for (int j = 0; j < 4; ++j) O[(size_t)(t0 + mt * 16 + fq * 4 + j) * 512 + h * 128 + slice * 16 + fr] = acc[j];
    }
    sacc = sacc * gl;
    sacc = MFMA16(kf[0], vf0, sacc); sacc = MFMA16(kf[1], vf1, sacc);
#pragma unroll
    for (int ks = 0; ks < 4; ++ks) { af[ks] = af1[ks]; af1[ks] = naf[ks]; }
#pragma unroll
    for (int ks = 0; ks < 2; ++ks) { kf[ks] = kf1[ks]; tf[ks] = tf1[ks]; kf1[ks] = nkf[ks]; tf1[ks] = ntf[ks]; }
#pragma unroll
    for (int j = 0; j < 4; ++j) { uu[j] = uu1[j]; uu1[j] = nuu[j]; }
    gl = gl1; gl1 = ngl;
  }
#undef SCAN_LOAD
}

DEVI void unit_conv(int wv, PP p, int l, int tile, unsigned char* shm) {
  const int tid = otid(wv), wid = tid >> 6, lane = tid & 63;
  u16* at = (u16*)shm; float* yt = (float*)(shm + 63488);
  const u16* Z = (const u16*)(p->ws + OFF_Z);
  const int t0 = tile * 32, s0 = t0 & 4095;
  {
    uint4 r1[8], r2[8];
#pragma unroll
    for (int i = 0; i < 8; ++i) { const int it = tid + i * 512, r = it >> 6, c8 = (it & 63) * 8; const int rr = (s0 - 30 + r >= 0 && it < 62 * 64) ? (r - 30) : 0;
      const u16* zr = Z + (ptrdiff_t)(t0 + rr) * ZW; r1[i] = *(const uint4*)(zr + c8); r2[i] = *(const uint4*)(zr + 512 + c8); }
#pragma unroll
    for (int i = 0; i < 8; ++i) { const int it = tid + i * 512, r = it >> 6, c8 = (it & 63) * 8;
      if (it < 62 * 64) { uint4 o = {0u, 0u, 0u, 0u};
        if (s0 - 30 + r >= 0) { float a1[8], a2[8]; unpack8(r1[i], a1); unpack8(r2[i], a2);
#pragma unroll
          for (int e = 0; e < 8; ++e) a1[e] *= sigmoidf_(a2[e]);
          o = pack8(a1); }
        *(uint4*)(at + r * 512 + c8) = o; } }
  }
  __syncthreads();
  {
    const int c = tid; float w[31];
    const float* cw = p->conv_a_w + (size_t)l * 31 * 512 + c;
#pragma unroll
    for (int k = 0; k < 31; ++k) w[k] = cw[k * 512];
    const float bias = p->conv_a_b[l * 512 + c];
    float acc[32];
#pragma unroll
    for (int t = 0; t < 32; ++t) acc[t] = bias;
#pragma unroll
    for (int r = 0; r < 62; ++r) { const float v = bf2f(at[r * 512 + c]);
#pragma unroll
      for (int t = 0; t < 32; ++t) if (r - t >= 0 && r - t <= 30) acc[t] += w[r - t] * v; }
#pragma unroll
    for (int t = 0; t < 32; ++t) yt[t * 512 + c] = acc[t];
  }
  __syncthreads();
  {
    const float* lg = p->ln_a_g + l * 512 + lane * 8; const float* lb = p->ln_a_b + l * 512 + lane * 8;
    u16* out = (u16*)(p->ws + OFF_BR);
#pragma unroll
    for (int tt = 0; tt < 4; ++tt) {
      const int t = wid * 4 + tt;
      const f32x4 v0 = *(const f32x4*)(yt + t * 512 + lane * 8), v1 = *(const f32x4*)(yt + t * 512 + lane * 8 + 4);
      float v[8] = {v0[0], v0[1], v0[2], v0[3], v1[0], v1[1], v1[2], v1[3]};
      float s = 0.f;
#pragma unroll
      for (int e = 0; e < 8; ++e) s += v[e];
      const float mean = wave_sum(s) * (1.f / 512.f); float s2 = 0.f;
#pragma unroll
      for (int e = 0; e < 8; ++e) { v[e] -= mean; s2 += v[e] * v[e]; }
      const float rstd = rsqrtf(wave_sum(s2) * (1.f / 512.f) + 1e-5f);
#pragma unroll
      for (int e = 0; e < 8; ++e) v[e] = siluf_(v[e] * rstd * lg[e] + lb[e]);
      *(uint4*)(out + (size_t)(t0 + t) * 512 + lane * 8) = pack8(v);
    }
  }
  __syncthreads();
}

DEVI void unit_gmlp(int wv, PP p, int l, int u, unsigned char* shm) {
  const int tid = otid(wv), wid = tid >> 6, lane = tid & 63, fr = lane & 15, fq = lane >> 4;
  const int chunk = u >> 2, g = u & 3, T0 = chunk * 128;
  u16* vT = (u16*)shm; u16* uT = vT + 128 * 136;
  const u16* Z = (const u16*)(p->ws + OFF_Z);
  {
    uint4 raw[16], ur[4];
#pragma unroll
    for (int tt = 0; tt < 16; ++tt) raw[tt] = *(const uint4*)(Z + (size_t)(T0 + wid * 16 + tt) * ZW + 3072 + 512 + lane * 8);
#pragma unroll
    for (int i = 0; i < 4; ++i) { const int it = tid + i * 512, r = it >> 4, c8 = (it & 15) * 8; ur[i] = *(const uint4*)(Z + (size_t)(T0 + r) * ZW + 3072 + g * 128 + c8); }
#pragma unroll
    for (int i = 0; i < 4; ++i) { const int it = tid + i * 512, r = it >> 4, c8 = (it & 15) * 8; *(uint4*)(uT + r * 136 + c8) = ur[i]; }
    const int cl = fr * 8; const float* lg = p->gm_ln_g + l * 512 + g * 128 + cl; const float* lb = p->gm_ln_b + l * 512 + g * 128 + cl;
#pragma unroll
    for (int tb = 0; tb < 16; tb += 4) {
      float v[4][8], s1[4], s2[4];
#pragma unroll
      for (int k = 0; k < 4; ++k) { unpack8(raw[tb + k], v[k]); float a = 0.f, b2 = 0.f;
#pragma unroll
        for (int e = 0; e < 8; ++e) { v[k][e] = geluf_(v[k][e]); a += v[k][e]; b2 += v[k][e] * v[k][e]; }
        s1[k] = a; s2[k] = b2; }
#pragma unroll
      for (int o = 1; o < 64; o <<= 1) {
#pragma unroll
        for (int k = 0; k < 4; ++k) { s1[k] += __shfl_xor(s1[k], o); s2[k] += __shfl_xor(s2[k], o); }
      }
      if (fq == g) {
#pragma unroll
        for (int k = 0; k < 4; ++k) {
          const int tl = wid * 16 + tb + k;
          const float mean = s1[k] * (1.f / 512.f), var = fmaxf(s2[k] * (1.f / 512.f) - mean * mean, 0.f), rstd = rsqrtf(var + 1e-5f);
#pragma unroll
          for (int e = 0; e < 8; ++e) vT[(cl + e) * 136 + tl] = f2bf((v[k][e] - mean) * rstd * lg[e] + lb[e]);
        }
      }
      __builtin_amdgcn_sched_barrier(0);
    }
  }
  __syncthreads();
  f32x4 acc[8];
#pragma unroll
  for (int nt = 0; nt < 8; ++nt) acc[nt] = (f32x4){0.f, 0.f, 0.f, 0.f};
  const float* Wg = p->gm_ws + ((size_t)l * 4 + g) * 16384;
#pragma unroll
  for (int ks = 0; ks < 4; ++ks) {
    if (ks * 32 <= wid * 16 + 15) {
      const int t = wid * 16 + fr, sb = ks * 32 + fq * 8;
      const f32x4 w0 = *(const f32x4*)(Wg + t * 128 + sb), w1 = *(const f32x4*)(Wg + t * 128 + sb + 4);
      float wv[8] = {w0[0], w0[1], w0[2], w0[3], w1[0], w1[1], w1[2], w1[3]};
#pragma unroll
      for (int e = 0; e < 8; ++e) if (sb + e > t) wv[e] = 0.f;
      const bf16x8 afr = as_bf8(pack8(wv));
#pragma unroll
      for (int nt = 0; nt < 8; ++nt) { const bf16x8 bfr = *(const bf16x8*)(vT + (nt * 16 + fr) * 136 + ks * 32 + fq * 8); acc[nt] = MFMA16(afr, bfr, acc[nt]); }
    }
  }
  u16* out = (u16*)(p->ws + OFF_BR) + (size_t)2 * T * 512;
#pragma unroll
  for (int j = 0; j < 4; ++j) {
    const int tl = wid * 16 + fq * 4 + j; const float bs = p->gm_bs[(l * 4 + g) * 128 + tl];
#pragma unroll
    for (int nt = 0; nt < 8; ++nt) {
      const int c = nt * 16 + fr;
      const float uu = geluf_(bf2f(uT[tl * 136 + c]));
      out[(size_t)(T0 + tl) * 512 + g * 128 + c] = f2bf(uu * (acc[nt][j] + bs));
    }
  }
  __syncthreads();
}

DEVI void unit_pool(int wv, PP p, int l, int u, unsigned char* shm) {
  const int tid = otid(wv), wid = tid >> 6, lane = tid & 63, fr = lane & 15, fq = lane >> 4;
  const int tile = u >> 2, gi = u & 3, win = 2 << gi, T0 = tile * 128, s0 = T0 & 4095;
  float* xs = (float*)shm; u16* pA = (u16*)(shm + 143 * 128 * 4);
  const u16* Z = (const u16*)(p->ws + OFF_Z);
  {
    uint4 raw[5];
#pragma unroll
    for (int i = 0; i < 5; ++i) { const int it = tid + i * 512, r = it >> 4, c8 = (it & 15) * 8; const int rr = (s0 - 15 + r >= 0 && it < 143 * 16) ? (r - 15) : 0;
      raw[i] = *(const uint4*)(Z + (ptrdiff_t)(T0 + rr) * ZW + 4096 + gi * 128 + c8); }
#pragma unroll
    for (int i = 0; i < 5; ++i) { const int it = tid + i * 512, r = it >> 4, c8 = (it & 15) * 8;
      if (it < 143 * 16) { float v[8]; unpack8(raw[i], v); const float mk = (s0 - 15 + r >= 0) ? 1.f : 0.f;
        *(f32x4*)(xs + r * 128 + c8) = (f32x4){v[0] * mk, v[1] * mk, v[2] * mk, v[3] * mk}; *(f32x4*)(xs + r * 128 + c8 + 4) = (f32x4){v[4] * mk, v[5] * mk, v[6] * mk, v[7] * mk}; } }
  }
  __syncthreads();
  {
    const int c = tid & 127, tstart = (tid >> 7) * 32;
    float S = 0.f;
    for (int k = 0; k < win; ++k) S += xs[(tstart + 15 - k) * 128 + c];
    for (int tt = 0; tt < 32; ++tt) {
      const int tl = tstart + tt;
      if (tt > 0) S += xs[(tl + 15) * 128 + c] - xs[(tl + 15 - win) * 128 + c];
      const int s = s0 + tl; const float cnt = (float)(s + 1 < win ? s + 1 : win);
      pA[tl * 136 + c] = f2bf(S / cnt - xs[(tl + 15) * 128 + c]);
    }
  }
  __syncthreads();
  f32x4 acc[8];
#pragma unroll
  for (int nt = 0; nt < 8; ++nt) acc[nt] = (f32x4){0.f, 0.f, 0.f, 0.f};
  const u16* Bt = (const u16*)(p->ws + OFF_POOLT) + (size_t)gi * 16384;
#pragma unroll
  for (int ks = 0; ks < 4; ++ks) {
    const bf16x8 afr = *(const bf16x8*)(pA + (wid * 16 + fr) * 136 + ks * 32 + fq * 8);
#pragma unroll
    for (int nt = 0; nt < 8; ++nt) { const bf16x8 bfr = *(const bf16x8*)(Bt + (nt * 16 + fr) * 128 + ks * 32 + fq * 8); acc[nt] = MFMA16(afr, bfr, acc[nt]); }
  }
  u16* out = (u16*)(p->ws + OFF_BR) + (size_t)3 * T * 512;
#pragma unroll
  for (int nt = 0; nt < 8; ++nt) {
    const int d = nt * 16 + fr; const float sc = p->pool_scale[l * 512 + gi * 128 + d];
#pragma unroll
    for (int j = 0; j < 4; ++j) { const int tl = wid * 16 + fq * 4 + j; out[(size_t)(T0 + tl) * 512 + gi * 128 + d] = f2bf(acc[nt][j] * sc); }
  }
  __syncthreads();
}

DEVI void phase_dn_post(int wv, PP p, int l) {
  const int tid = otid(wv), wid = tid >> 6, lane = tid & 63;
  const int gw = blockIdx.x * 8 + wid, nw = gridDim.x * 8;
  const float* O = (const float*)(p->ws + OFF_O); const u16* Z = (const u16*)(p->ws + OFF_Z);
  u16* out = (u16*)(p->ws + OFF_BR) + (size_t)1 * T * 512;
  const float* ng = p->dn_norm_g + l * 128 + (lane & 15) * 8;
  float gn[8];
#pragma unroll
  for (int e = 0; e < 8; ++e) gn[e] = ng[e];
  for (int row0 = gw; row0 < T; row0 += 4 * nw) {
    f32x4 a[4], b2[4]; uint4 gr[4]; float ss[4];
#pragma unroll
    for (int r = 0; r < 4; ++r) { const size_t row = (size_t)row0 + (size_t)r * nw;
      a[r] = *(const f32x4*)(O + row * 512 + lane * 8); b2[r] = *(const f32x4*)(O + row * 512 + lane * 8 + 4); gr[r] = *(const uint4*)(Z + row * ZW + 2560 + lane * 8); }
#pragma unroll
    for (int r = 0; r < 4; ++r) ss[r] = (a[r][0] * a[r][0] + a[r][1] * a[r][1]) + (a[r][2] * a[r][2] + a[r][3] * a[r][3]) + (b2[r][0] * b2[r][0] + b2[r][1] * b2[r][1]) + (b2[r][2] * b2[r][2] + b2[r][3] * b2[r][3]);
#pragma unroll
    for (int o = 1; o < 16; o <<= 1) {
#pragma unroll
      for (int r = 0; r < 4; ++r) ss[r] += __shfl_xor(ss[r], o);
    }
#pragma unroll
    for (int r = 0; r < 4; ++r) { const size_t row = (size_t)row0 + (size_t)r * nw;
      const float rs = rsqrtf(ss[r] * (1.f / 128.f) + 1e-6f);
      float gt[8]; unpack8(gr[r], gt);
      float v[8] = {a[r][0], a[r][1], a[r][2], a[r][3], b2[r][0], b2[r][1], b2[r][2], b2[r][3]};
#pragma unroll
      for (int e = 0; e < 8; ++e) v[e] = v[e] * rs * gn[e] * siluf_(gt[e]);
      *(uint4*)(out + row * 512 + lane * 8) = pack8(v); }
  }
}

DEVI void phase_attn(int wv, PP p, unsigned char* shm) {
  const u16* Q = (const u16*)(p->ws + OFF_Q); const u16* KB = (const u16*)(p->ws + OFF_KB); const u16* VT = (const u16*)(p->ws + OFF_VT);
  u16* AO = (u16*)(p->ws + OFF_AO);
  u16* L = (u16*)shm;
  for (int u = blockIdx.x; u < 512; u += gridDim.x) {
    const int tid = otid(wv), wid = tid >> 6, lane = tid & 63, fr = lane & 15, fq = lane >> 4;
    const int qt = u & 31, head = (u >> 5) & 3, b = u >> 7;
    const int q0 = b * 4096 + qt * 128 + wid * 16;
    {
      const u16* Kg = KB + (size_t)(b * 256) * 1024 + head * 256;
      uint4 tmp[16];
#pragma unroll
      for (int i = 0; i < 16; ++i) { const int it = tid + i * 512, r = it >> 5, c = (it & 31) * 8; tmp[i] = *(const uint4*)(Kg + (size_t)r * 1024 + c); }
#pragma unroll
      for (int i = 0; i < 16; ++i) { const int it = tid + i * 512, r = it >> 5, c = (it & 31) * 8; *(uint4*)(L + r * 264 + c) = tmp[i]; }
    }
    const u16* Qp = Q + (size_t)(q0 + fr) * 1024 + head * 256 + fq * 8;
    bf16x8 qf[8];
#pragma unroll
    for (int kk = 0; kk < 8; ++kk) qf[kk] = *(const bf16x8*)(Qp + kk * 32);
    __syncthreads();
    f32x4 sc[16];
#pragma unroll
    for (int mt = 0; mt < 16; ++mt) {
      f32x4 a = {0.f, 0.f, 0.f, 0.f};
#pragma unroll
      for (int kk = 0; kk < 8; ++kk) { const bf16x8 kfr = *(const bf16x8*)(L + (mt * 16 + fr) * 264 + kk * 32 + fq * 8); a = MFMA16(kfr, qf[kk], a); }
      sc[mt] = a;
      if ((mt & 3) == 3) __builtin_amdgcn_sched_barrier(0);
    }
    __syncthreads();
    uint4 vtmp[8];
    const u16* Vg = VT + (size_t)(b * 4 + head) * 65536;
#pragma unroll
    for (int i = 0; i < 8; ++i) { const int it = tid + i * 512, r = it >> 5, c = (it & 31) * 8; vtmp[i] = *(const uint4*)(Vg + (size_t)r * 256 + c); }
    float mx = -3.0e38f;
#pragma unroll
    for (int mt = 0; mt < 16; ++mt)
#pragma unroll
      for (int j = 0; j < 4; ++j) mx = fmaxf(mx, sc[mt][j]);
    mx = fmaxf(mx, __shfl_xor(mx, 16)); mx = fmaxf(mx, __shfl_xor(mx, 32));
    float sum = 0.f;
#pragma unroll
    for (int mt = 0; mt < 16; ++mt)
#pragma unroll
      for (int j = 0; j < 4; ++j) { const float e = exp2f((sc[mt][j] - mx) * (1.4426950408889634f / 16.f)); sum += e; sc[mt][j] = e; }
    sum += __shfl_xor(sum, 16); sum += __shfl_xor(sum, 32);
    const float inv = 1.f / sum;
    bf16x8 pf[8];
#pragma unroll
    for (int t2 = 0; t2 < 8; ++t2) { uint4 o; o.x = pk2(sc[2 * t2][0], sc[2 * t2][1]); o.y = pk2(sc[2 * t2][2], sc[2 * t2][3]); o.z = pk2(sc[2 * t2 + 1][0], sc[2 * t2 + 1][1]); o.w = pk2(sc[2 * t2 + 1][2], sc[2 * t2 + 1][3]); pf[t2] = as_bf8(o); }
#pragma unroll
    for (int i = 0; i < 8; ++i) { const int it = tid + i * 512, r = it >> 5, c = (it & 31) * 8; *(uint4*)(L + r * 264 + c) = vtmp[i]; }
#pragma unroll
    for (int i = 0; i < 8; ++i) { const int it = tid + (i + 8) * 512, r = it >> 5, c = (it & 31) * 8; vtmp[i] = *(const uint4*)(Vg + (size_t)r * 256 + c); }
#pragma unroll
    for (int i = 0; i < 8; ++i) { const int it = tid + (i + 8) * 512, r = it >> 5, c = (it & 31) * 8; *(uint4*)(L + r * 264 + c) = vtmp[i]; }
    __syncthreads();
    u16* op = AO + (size_t)(q0 + fr) * 1024 + head * 256 + fq * 4;
#pragma unroll
    for (int dt = 0; dt < 16; ++dt) {
      f32x4 o = {0.f, 0.f, 0.f, 0.f};
#pragma unroll
      for (int t2 = 0; t2 < 8; ++t2) { const bf16x8 vfr = *(const bf16x8*)(L + (dt * 16 + fr) * 264 + t2 * 32 + fq * 8); o = MFMA16(vfr, pf[t2], o); }
      uint2 st; st.x = pk2(o[0] * inv, o[1] * inv); st.y = pk2(o[2] * inv, o[3] * inv);
      *(uint2*)(op + dt * 16) = st;
      if ((dt & 3) == 3) __builtin_amdgcn_sched_barrier(0);
    }
    __syncthreads();
  }
}

#define XB_TMO      128
#define XB_XCNT(j)  (256  + 64 * (j))
#define XB_XSUB(j)  (1280 + 64 * (j))
#define XB_XGEN(j)  (2304 + 64 * (j))
#define XB_TOP      3328
#define XB_TOPGEN   3392
#define XCD_BAR_WORDS 3456
#define XB_SPIN_CAP (1u << 18)
#define XLAS __attribute__((address_space(3)))

__device__ __forceinline__ unsigned xb_ld(unsigned* p)              { return __hip_atomic_load(p, __ATOMIC_RELAXED, __HIP_MEMORY_SCOPE_AGENT); }
__device__ __forceinline__ unsigned xb_add(unsigned* p, unsigned v) { return __hip_atomic_fetch_add(p, v, __ATOMIC_RELAXED, __HIP_MEMORY_SCOPE_AGENT); }
__device__ __forceinline__ unsigned xb_xcc_id() { return (unsigned)__builtin_amdgcn_s_getreg((3 << 11) | 20) & 0xFu; }
#define XB_SPIN(cond, bar) do { unsigned _sp = 0; while (cond) { __builtin_amdgcn_s_sleep(1); \
    if ((++_sp & 255u) == 0u) { if (xb_ld(&(bar)[XB_TMO])) break; if (_sp > XB_SPIN_CAP) { atomicAdd(&(bar)[XB_TMO], 1u); break; } } } } while (0)

struct XcdBarrier {
    int wv; unsigned* bar; unsigned x;
    volatile XLAS unsigned* st;
};

__device__ __forceinline__ XcdBarrier xcd_barrier_post(int wv, unsigned* bar, volatile XLAS unsigned* st) {
    XcdBarrier b; b.wv = wv; b.bar = bar; b.x = xb_xcc_id(); b.st = st;
    if (wv == 0 && lane_id() == 0) (void)xb_add(&bar[XB_XCNT(b.x)], 1u);
    return b;
}
__device__ __forceinline__ void xcd_barrier_complete(unsigned* bar, unsigned x, unsigned& nloc, unsigned& nx) {
    const unsigned G = gridDim.x * gridDim.y * gridDim.z;
    unsigned sum, cnt, mine, sp = 0u;
    for (;;) {
        sum = 0u; cnt = 0u; mine = 0u;
#pragma unroll
        for (unsigned j = 0; j < 16; ++j) { const unsigned c = xb_ld(&bar[XB_XCNT(j)]); sum += c; cnt += (c > 0u) ? 1u : 0u; mine = (j == x) ? c : mine; }
        if (sum == G) break;
        __builtin_amdgcn_s_sleep(1);
        if ((++sp & 255u) == 0u) { if (xb_ld(&bar[XB_TMO])) break; if (sp > XB_SPIN_CAP) { atomicAdd(&bar[XB_TMO], 1u); break; } }
    }
    nloc = mine > 0u ? mine : 1u; nx = cnt > 0u ? cnt : 1u;
}

__device__ __forceinline__ void xcd_barrier(const XcdBarrier& b) {
    asm volatile("s_waitcnt vmcnt(0)" ::: "memory");
    __syncthreads();
    if (b.wv == 0 && lane_id() == 0) {
        unsigned* bar = b.bar;
        __builtin_amdgcn_s_waitcnt(0);
        unsigned nloc = b.st[0], nx = b.st[1];
        if (nloc == 0u) { xcd_barrier_complete(bar, b.x, nloc, nx); b.st[0] = nloc; b.st[1] = nx; }
        const unsigned old = xb_add(&bar[XB_XSUB(b.x)], 1u);
        const unsigned gen = old / nloc;
        if (old + 1u == (gen + 1u) * nloc) {
            __builtin_amdgcn_fence(__ATOMIC_RELEASE, "agent");
            asm volatile("s_waitcnt vmcnt(0)" ::: "memory");
            const unsigned og = xb_add(&bar[XB_TOP], 1u);
            const unsigned tg = og / nx;
            if (og + 1u == (tg + 1u) * nx) xb_add(&bar[XB_TOPGEN], 1u);
            else XB_SPIN(xb_ld(&bar[XB_TOPGEN]) == tg, bar);
            __builtin_amdgcn_fence(__ATOMIC_ACQUIRE, "agent");
            xb_add(&bar[XB_XGEN(b.x)], 1u);
            asm volatile("s_waitcnt vmcnt(0)" ::: "memory");
        } else {
            XB_SPIN(xb_ld(&bar[XB_XGEN(b.x)]) == gen, bar);
            __builtin_amdgcn_fence(__ATOMIC_ACQUIRE, "agent");
            asm volatile("s_waitcnt vmcnt(0)" ::: "memory");
        }
    }
    __syncthreads();
}

#ifndef PROBE_ID
#define PROBE_ID 0
#endif
#define REPS(id) (PROBE_ID == (id) ? 3 : 1)
__global__ void __launch_bounds__(512, 2) mega(Params p_unused) {
  PP p = (PP)__builtin_amdgcn_kernarg_segment_ptr();
  extern __shared__ __attribute__((aligned(16))) unsigned char shm[];
  cg::grid_group grid = cg::this_grid();
  unsigned char* ws = p->ws;
  const int bid = blockIdx.x, G = gridDim.x;
  const int wv = __builtin_amdgcn_readfirstlane((int)threadIdx.x >> 6);
  if (G == 0x7fffffff) grid.sync();
  volatile XLAS unsigned* xst = (volatile XLAS unsigned*)(shm + LDS_BYTES - 16);
  if (wv == 0 && lane_id() == 0) { xst[0] = 0u; xst[1] = 0u; }
  __syncthreads();
  XcdBarrier xb = xcd_barrier_post(wv, (unsigned*)(ws + OFF_BAR), xst);
#ifdef PROBE_A
  float* tacc = (float*)(shm + LDS_BYTES - 128); unsigned long long* tsp = (unsigned long long*)(shm + LDS_BYTES - 48);
  if (threadIdx.x == 0) { for (int i = 0; i < 16; ++i) tacc[i] = 0.f; *tsp = wall_clock64(); }
#define GSYNC(id) do { xcd_barrier(xb); if (threadIdx.x == 0) { const unsigned long long t_ = wall_clock64(); tacc[id] += (float)(t_ - *tsp) * 0.01f; *tsp = t_; } } while (0)
#else
#define GSYNC(id) xcd_barrier(xb)
#endif
#pragma unroll 1
  for (int l = 0; l < DEPTH; ++l) {
    unsigned char* ws = opq(p)->ws;
    for (int rp = 0; rp < REPS(10); ++rp) { if (rp) GSYNC(0); phase_prep(wv, opq(p), l, shm); }
    GSYNC(0);
    { EpiStore<0> E; E.O = (u16*)(ws + OFF_Z); E.ldc = ZW; run_gemm(wv, shm, (const u16*)(ws + OFF_HM), (const u16*)(ws + OFF_WT_IN), T, ZW, 1024, E); }
    if (G == 256) { if (bid >= 192) { EpiKV E; E.Kb = (u16*)(ws + OFF_KB); E.Vt = (u16*)(ws + OFF_VT); run_gemm_sub(wv, shm, (const u16*)(ws + OFF_MEMN), (const u16*)(ws + OFF_WT_KV), 1024, 2048, 1024, E, 64, bid - 192); } }
    else { EpiKV E; E.Kb = (u16*)(ws + OFF_KB); E.Vt = (u16*)(ws + OFF_VT); run_gemm(wv, shm, (const u16*)(ws + OFF_MEMN), (const u16*)(ws + OFF_WT_KV), 1024, 2048, 1024, E); }
    GSYNC(1);
    for (int rp = 0; rp < REPS(2); ++rp) {
    if (rp) GSYNC(2);
    for (int r12 = 0; r12 < REPS(12); ++r12) for (int u = bid; u < 512; u += G) unit_conv(wv, opq(p), l, u, shm);
    for (int r13 = 0; r13 < REPS(13); ++r13) for (int u = bid; u < 512; u += G) unit_gmlp(wv, opq(p), l, u, shm);
    for (int r14 = 0; r14 < REPS(14); ++r14) for (int u = bid; u < 512; u += G) unit_pool(wv, opq(p), l, u, shm);
    for (int r11 = 0; r11 < REPS(11); ++r11) phase_dn_pre(wv, opq(p), l, shm);
    }
    GSYNC(2);
    for (int rp = 0; rp < REPS(3); ++rp) {
    if (rp) GSYNC(3);
    if (bid < 128) { for (int r5 = 0; r5 < REPS(5); ++r5) { phase_dn_scan(wv, opq(p), shm); __syncthreads(); } }
    else {
      { EpiMerge<1> E; E.Mg = (u16*)(ws + OFF_HM); E.Zg = (const u16*)(ws + OFF_Z) + 4608; run_gemm_sub(wv, shm, (const u16*)(ws + OFF_BR), (const u16*)(ws + OFF_WT_BR), T, 1024, 512, E, G - 128, bid - 128); }
#pragma unroll 1
      for (int i = 2; i < 3; ++i) { EpiMerge<0> E; E.Mg = (u16*)(ws + OFF_HM); E.Zg = (const u16*)(ws + OFF_Z) + 4608 + i * 1024;
        run_gemm_sub(wv, shm, (const u16*)(ws + OFF_BR) + (size_t)i * T * 512, (const u16*)(ws + OFF_WT_BR) + (size_t)i * 1024 * 512, T, 1024, 512, E, G - 128, bid - 128); }
    }
    }
    GSYNC(3);
    for (int r4 = 0; r4 < REPS(4); ++r4) phase_dn_post(wv, opq(p), l);
    { EpiMerge<0> E; E.Mg = (u16*)(ws + OFF_HM); E.Zg = (const u16*)(ws + OFF_Z) + 4608 + 3 * 1024;
      run_gemm(wv, shm, (const u16*)(ws + OFF_BR) + (size_t)3 * T * 512, (const u16*)(ws + OFF_WT_BR) + (size_t)3 * 1024 * 512, T, 1024, 512, E); }
    GSYNC(4);
    { EpiMerge<0> E; E.Mg = (u16*)(ws + OFF_HM); E.Zg = (const u16*)(ws + OFF_Z) + 4608 + 1024;
      run_gemm(wv, shm, (const u16*)(ws + OFF_BR) + (size_t)T * 512, (const u16*)(ws + OFF_WT_BR) + (size_t)1024 * 512, T, 1024, 512, E); }
    GSYNC(5);
    { EpiResid E; E.X = opq(p)->out; E.ldc = 1024; run_gemm(wv, shm, (const u16*)(ws + OFF_HM), (const u16*)(ws + OFF_WT_OUT), T, 1024, 1024, E); }
    GSYNC(6);
    for (int r7 = 0; r7 < REPS(7); ++r7) phase_norm(wv, opq(p), p->norm_xa + l * 1024, shm);
    GSYNC(7);
    { EpiStore<0> E; E.O = (u16*)(ws + OFF_Q); E.ldc = 1024; run_gemm(wv, shm, (const u16*)(ws + OFF_HM), (const u16*)(ws + OFF_WT_Q), T, 1024, 1024, E); }
    GSYNC(8);
    for (int rp = 0; rp < REPS(9); ++rp) { if (rp) GSYNC(9); phase_attn(wv, opq(p), shm); }
    GSYNC(9);
    { EpiResid E; E.X = opq(p)->out; E.ldc = 1024; run_gemm(wv, shm, (const u16*)(ws + OFF_AO), (const u16*)(ws + OFF_WT_O), T, 1024, 1024, E); }
    GSYNC(10);
    phase_norm(wv, opq(p), p->norm_mlp + l * 1024, shm);
    GSYNC(11);
    { EpiStore<1> E; E.O = (u16*)(ws + OFF_HID); E.ldc = FF; run_gemm(wv, shm, (const u16*)(ws + OFF_HM), (const u16*)(ws + OFF_WT_1), T, FF, 1024, E); }
    GSYNC(12);
    { EpiResid E; E.X = opq(p)->out; E.ldc = 1024; run_gemm(wv, shm, (const u16*)(ws + OFF_HID), (const u16*)(ws + OFF_WT_2), T, 1024, FF, E); }
    GSYNC(13);
  }
  phase_final(wv, opq(p));
#ifdef PROBE_A
  if (bid == 0) { __syncthreads(); if (threadIdx.x == 0) p->out[0] += tacc[PROBE_A]; const float bv = tacc[PROBE_B] * 0.1f; __syncthreads(); for (int i = threadIdx.x; i < 65536; i += 512) p->out[1024 + i] += bv; }
#endif
}

extern "C" void kernel_launch(void* const* d_in, const int* in_sizes, int n_in, void* d_out, int out_size,
                              void* d_ws, size_t ws_size, hipStream_t stream) {
  static int grid_blocks = 0;
  if (!grid_blocks) {
    int dev = 0, cus = 0, per_cu = 0;
    (void)hipGetDevice(&dev);
    (void)hipDeviceGetAttribute(&cus, hipDeviceAttributeMultiprocessorCount, dev);
    (void)hipFuncSetAttribute((const void*)mega, hipFuncAttributeMaxDynamicSharedMemorySize, LDS_BYTES);
    (void)hipOccupancyMaxActiveBlocksPerMultiprocessor(&per_cu, (const void*)mega, 512, (size_t)LDS_BYTES);
    if (n_in != 29 || ws_size < WS_END || per_cu < 1 || cus < 136) fprintf(stderr, "kernel_launch: unexpected configuration n_in %d ws %zu (need %zu) per_cu %d cus %d\n", n_in, ws_size, (size_t)WS_END, per_cu, cus);
    grid_blocks = cus > 256 ? 256 : cus;
  }
  Params p{};
  const float** pp = (const float**)&p;
  for (int i = 0; i < 29; ++i) pp[i] = (const float*)d_in[i];
  p.out = (float*)d_out; p.ws = (unsigned char*)d_ws;
  (void)hipMemsetAsync((unsigned char*)d_ws + OFF_BAR, 0, 16384, stream);
  void* args[] = {&p};
  hipError_t e = hipLaunchCooperativeKernel((void*)mega, dim3(grid_blocks), dim3(512), args, (size_t)LDS_BYTES, stream);
  if (e != hipSuccess) fprintf(stderr, "cooperative launch failed: %s (grid %d)\n", hipGetErrorString(e), grid_blocks);
}
```
